# Optimizing an MI355X kernel written in HIP

```python
import math
import jax, jax.numpy as jnp
from jax import lax
import numpy as np

D_MODEL = 1024
BATCH = 8
SEQ = 4096
DEPTH = 1
DEC_BATCH = 1
DEC_SEQ = 16384
PAST_LEN = 128

N_HEADS = 8
QK_NOPE = 64
QK_ROPE = 32
V_DIM = 64
Q_RANK = 256
KV_RANK = 128
ATTN_W = N_HEADS * V_DIM
Q_BLOCK = 128
ROPE_THETA = 10000.0
SSM_W = D_MODEL // 2
SSM_GROUP = 16
SSM_GROUPS = SSM_W // SSM_GROUP
SSM_STATE = 64
N_DIR = 2
DT_MIN = 1e-3
DT_MAX = 1e-1
IN_W = Q_RANK + KV_RANK + QK_ROPE + SSM_W
MIX_W = ATTN_W + SSM_W
D_FF = 4 * D_MODEL
EPS = 1e-6

kernel_name = "hymba_s5_mla_encoder"


def rms_norm(x, g):
    xf = x.astype(jnp.float32)
    y = xf * lax.rsqrt(jnp.mean(xf * xf, axis=-1, keepdims=True) + EPS)
    return (y * g.astype(jnp.float32)).astype(x.dtype)


def rope_tables(length):
    pos = jnp.arange(length, dtype=jnp.float32)
    inv = ROPE_THETA ** (-jnp.arange(0, QK_ROPE, 2, dtype=jnp.float32) / QK_ROPE)
    ang = pos[:, None] * inv[None, :]
    return jnp.cos(ang), jnp.sin(ang)


def apply_rope(x, cos, sin):
    half = QK_ROPE // 2
    xf = x.astype(jnp.float32)
    x1, x2 = xf[..., :half], xf[..., half:]
    return jnp.concatenate([x1 * cos - x2 * sin, x2 * cos + x1 * sin], axis=-1).astype(x.dtype)


def mla_attention(c_q, c_kv, k_rope_raw, q_norm_g, w_uq, kv_norm_g, w_ukv):
    b, l, _ = c_q.shape
    q = (rms_norm(c_q, q_norm_g) @ w_uq).reshape(b, l, N_HEADS, QK_NOPE + QK_ROPE)
    kv = (rms_norm(c_kv, kv_norm_g) @ w_ukv).reshape(b, l, N_HEADS, QK_NOPE + V_DIM)
    k_nope, v = kv[..., :QK_NOPE], kv[..., QK_NOPE:]
    cos, sin = rope_tables(l)
    q_rope = apply_rope(q[..., QK_NOPE:], cos[:, None, :], sin[:, None, :])
    k_rope = apply_rope(k_rope_raw, cos, sin)
    q = jnp.concatenate([q[..., :QK_NOPE], q_rope], axis=-1)
    k = jnp.concatenate(
        [k_nope, jnp.broadcast_to(k_rope[:, :, None, :], (b, l, N_HEADS, QK_ROPE))], axis=-1)
    scale = 1.0 / math.sqrt(QK_NOPE + QK_ROPE)
    nb = l // Q_BLOCK
    q_blocks = q.reshape(b, nb, Q_BLOCK, N_HEADS, QK_NOPE + QK_ROPE).transpose(1, 0, 2, 3, 4)

    def attend(qb):
        s = jnp.einsum('bqhd,bkhd->bhqk', qb, k).astype(jnp.float32) * scale
        p = jax.nn.softmax(s, axis=-1).astype(v.dtype)
        return jnp.einsum('bhqk,bkhd->bqhd', p, v)

    o = lax.map(attend, q_blocks)
    return o.transpose(1, 0, 2, 3, 4).reshape(b, l, ATTN_W)


def _ssm_combine(left, right):
    a1, b1 = left
    a2, b2 = right
    return a1 * a2, a2 * b1 + b2


def s5_bidirectional_glu(u, lam_re, lam_im, log_dt, b_re, b_im, c_re, c_im, d_skip, w_glu, b_glu):
    bsz, l, _ = u.shape
    ug = u.astype(jnp.float32).reshape(bsz, l, SSM_GROUPS, SSM_GROUP)
    uc = ug.astype(jnp.complex64)
    y = jnp.zeros_like(ug)
    for d in range(N_DIR):
        lam = lax.complex(lam_re[d].astype(jnp.float32), lam_im[d].astype(jnp.float32))
        dt = jnp.exp(log_dt[d].astype(jnp.float32))[:, None]
        a_bar = jnp.exp(lam * dt)
        b_mat = lax.complex(b_re[d].astype(jnp.float32), b_im[d].astype(jnp.float32))
        c_mat = lax.complex(c_re[d].astype(jnp.float32), c_im[d].astype(jnp.float32))
        b_bar = ((a_bar - 1.0) / lam)[..., None] * b_mat
        bu = jnp.einsum('blgh,gnh->blgn', uc, b_bar)
        a_seq = jnp.broadcast_to(a_bar, bu.shape)
        _, states = lax.associative_scan(_ssm_combine, (a_seq, bu), axis=1, reverse=(d == 1))
        y = y + jnp.real(jnp.einsum('blgn,ghn->blgh', states, c_mat))
    y = y + d_skip.astype(jnp.float32).reshape(SSM_GROUPS, SSM_GROUP) * ug
    y = y.reshape(bsz, l, SSM_W).astype(u.dtype)
    g = jax.nn.gelu(y)
    return g * jax.nn.sigmoid(g @ w_glu + b_glu)


def encoder_layer(x, norm1_g, w_in, q_norm_g, w_uq, kv_norm_g, w_ukv,
                  lam_re, lam_im, log_dt, b_re, b_im, c_re, c_im, d_skip, w_glu, b_glu,
                  attn_out_g, ssm_out_g, w_out, norm2_g, w_mlp1, w_mlp2):
    h = rms_norm(x, norm1_g)
    proj = h @ w_in
    c_q, c_kv, k_rope, u = jnp.split(
        proj, [Q_RANK, Q_RANK + KV_RANK, Q_RANK + KV_RANK + QK_ROPE], axis=-1)
    a = mla_attention(c_q, c_kv, k_rope, q_norm_g, w_uq, kv_norm_g, w_ukv)
    s = s5_bidirectional_glu(u, lam_re, lam_im, log_dt, b_re, b_im, c_re, c_im,
                             d_skip, w_glu, b_glu)
    mixed = jnp.concatenate([rms_norm(a, attn_out_g), rms_norm(s, ssm_out_g)], axis=-1)
    x = x + mixed @ w_out
    h = rms_norm(x, norm2_g)
    x = x + jnp.square(jax.nn.relu(h @ w_mlp1)) @ w_mlp2
    return x


def trunk(x, norm1_g, w_in, q_norm_g, w_uq, kv_norm_g, w_ukv,
          lam_re, lam_im, log_dt, b_re, b_im, c_re, c_im, d_skip, w_glu, b_glu,
          attn_out_g, ssm_out_g, w_out, norm2_g, w_mlp1, w_mlp2, final_g):
    for i in range(DEPTH):
        x = encoder_layer(x, norm1_g[i], w_in[i], q_norm_g[i], w_uq[i], kv_norm_g[i], w_ukv[i],
                          lam_re[i], lam_im[i], log_dt[i], b_re[i], b_im[i], c_re[i], c_im[i],
                          d_skip[i], w_glu[i], b_glu[i], attn_out_g[i], ssm_out_g[i], w_out[i],
                          norm2_g[i], w_mlp1[i], w_mlp2[i])
    return rms_norm(x, final_g)


def setup_inputs(seed: int = 0) -> dict:
    key = jax.random.key(seed)
    ks = jax.random.split(key, 32)
    f32 = jnp.float32

    def nrm(k, shape, scale):
        return jax.random.normal(k, shape, f32) * scale

    def gain(k, shape):
        return 1.0 + 0.02 * jax.random.normal(k, shape, f32)

    G, N, H = SSM_GROUPS, SSM_STATE, SSM_GROUP
    lam_re = -0.5 + 0.01 * jax.random.normal(ks[8], (DEPTH, N_DIR, G, N), f32)
    lam_im = math.pi * jnp.arange(N, dtype=f32) + 0.01 * jax.random.normal(ks[9], (DEPTH, N_DIR, G, N), f32)
    log_dt = jax.random.uniform(ks[10], (DEPTH, N_DIR, G), f32,
                                minval=math.log(DT_MIN), maxval=math.log(DT_MAX))
    return {
        "x_prompt": jax.random.normal(ks[0], (BATCH, SEQ, D_MODEL), f32),
        "x_sample": jax.random.normal(ks[1], (DEC_BATCH, DEC_SEQ, D_MODEL), f32),
        "norm1_g": gain(ks[2], (DEPTH, D_MODEL)),
        "w_in": nrm(ks[3], (DEPTH, D_MODEL, IN_W), D_MODEL ** -0.5),
        "q_norm_g": gain(ks[4], (DEPTH, Q_RANK)),
        "w_uq": nrm(ks[5], (DEPTH, Q_RANK, N_HEADS * (QK_NOPE + QK_ROPE)), Q_RANK ** -0.5),
        "kv_norm_g": gain(ks[6], (DEPTH, KV_RANK)),
        "w_ukv": nrm(ks[7], (DEPTH, KV_RANK, N_HEADS * (QK_NOPE + V_DIM)), KV_RANK ** -0.5),
        "lam_re": lam_re,
        "lam_im": lam_im,
        "log_dt": log_dt,
        "b_re": nrm(ks[11], (DEPTH, N_DIR, G, N, H), (2.0 * H) ** -0.5),
        "b_im": nrm(ks[12], (DEPTH, N_DIR, G, N, H), (2.0 * H) ** -0.5),
        "c_re": nrm(ks[13], (DEPTH, N_DIR, G, H, N), (2.0 * N) ** -0.5),
        "c_im": nrm(ks[14], (DEPTH, N_DIR, G, H, N), (2.0 * N) ** -0.5),
        "d_skip": nrm(ks[15], (DEPTH, SSM_W), 1.0),
        "w_glu": nrm(ks[16], (DEPTH, SSM_W, SSM_W), SSM_W ** -0.5),
        "b_glu": nrm(ks[17], (DEPTH, SSM_W), 0.01),
        "attn_out_g": gain(ks[18], (DEPTH, ATTN_W)),
        "ssm_out_g": gain(ks[19], (DEPTH, SSM_W)),
        "w_out": nrm(ks[20], (DEPTH, MIX_W, D_MODEL), MIX_W ** -0.5),
        "norm2_g": gain(ks[21], (DEPTH, D_MODEL)),
        "w_mlp1": nrm(ks[22], (DEPTH, D_MODEL, D_FF), D_MODEL ** -0.5),
        "w_mlp2": nrm(ks[23], (DEPTH, D_FF, D_MODEL), D_FF ** -0.5),
        "final_g": gain(ks[24], (D_MODEL,)),
    }


def reference(x_prompt, x_sample, norm1_g, w_in, q_norm_g, w_uq, kv_norm_g, w_ukv,
              lam_re, lam_im, log_dt, b_re, b_im, c_re, c_im, d_skip, w_glu, b_glu,
              attn_out_g, ssm_out_g, w_out, norm2_g, w_mlp1, w_mlp2, final_g):
    y_prompt = trunk(x_prompt, norm1_g, w_in, q_norm_g, w_uq, kv_norm_g, w_ukv,
                     lam_re, lam_im, log_dt, b_re, b_im, c_re, c_im, d_skip, w_glu, b_glu,
                     attn_out_g, ssm_out_g, w_out, norm2_g, w_mlp1, w_mlp2, final_g)
    y_sample = trunk(x_sample, norm1_g, w_in, q_norm_g, w_uq, kv_norm_g, w_ukv,
                     lam_re, lam_im, log_dt, b_re, b_im, c_re, c_im, d_skip, w_glu, b_glu,
                     attn_out_g, ssm_out_g, w_out, norm2_g, w_mlp1, w_mlp2, final_g)
    return (y_prompt, y_sample)
```

```cpp
#include <hip/hip_runtime.h>
#include <cstdint>
#include <cstdio>

typedef unsigned short bf16_t;
typedef short bf16x8 __attribute__((ext_vector_type(8)));
typedef float f32x4 __attribute__((ext_vector_type(4)));
typedef float f32x2 __attribute__((ext_vector_type(2)));
typedef unsigned u32x4 __attribute__((ext_vector_type(4)));
typedef unsigned u32x2 __attribute__((ext_vector_type(2)));
#define LAS __attribute__((address_space(3)))

constexpr int DM = 1024, M_TOK = 49152, M_PROMPT = 32768, SEQ_P = 4096, SEQ_S = 16384;
constexpr int NH = 8, DQK = 96, DNOPE = 64, DROPE = 32, DV = 64, QR = 256, KVR = 128;
constexpr int SSMW = 512, NG = 32, GH = 16, NS = 64, DFF = 4096, INW = 928;
constexpr int CT = 16, NCHUNK = M_TOK / CT;
constexpr float EPS = 1e-6f;
constexpr float QSCALE = 0.10206207261596575f * 1.4426950408889634f;

constexpr size_t MiB = 1u << 20;
constexpr size_t WS_CTL = 0;
constexpr size_t WS_WIN = 1 * MiB;
constexpr size_t WS_WUQ = 3 * MiB;
constexpr size_t WS_WUKV = 3 * MiB + 384 * 1024;
constexpr size_t WS_WGLU = 4 * MiB;
constexpr size_t WS_WOUT = 5 * MiB;
constexpr size_t WS_W1 = 7 * MiB;
constexpr size_t WS_W2 = 15 * MiB;
constexpr size_t WS_MQ = 23 * MiB;
constexpr size_t WS_SP = 31 * MiB;
constexpr size_t WS_ROPE = 35 * MiB;
constexpr size_t WS_STAT = 37 * MiB;
constexpr size_t WS_AT = 39 * MiB;
constexpr size_t WS_PROJ = 40 * MiB;
constexpr size_t WS_UA = 88 * MiB;
constexpr size_t WS_XB = 184 * MiB;
constexpr size_t WS_MIX = 312 * MiB;
constexpr size_t WS_END = 408 * MiB;
enum { ST_RSTD1 = 0, ST_SSQ = 1, ST_SSKV = 2, ST_SSA = 3, ST_SSS = 4, ST_SSX1 = 5, ST_SSX2 = 6 };

struct Params {
    const float* in[25];
    float* out;
    unsigned char* ws;
    int ph_lo, ph_hi;
};

__device__ __forceinline__ unsigned f2bf(float f) { unsigned u = __builtin_bit_cast(unsigned, f); return (u + 0x7fffu + ((u >> 16) & 1u)) >> 16; }
__device__ __forceinline__ unsigned pk2(float lo, float hi) { return f2bf(lo) | (f2bf(hi) << 16); }
__device__ __forceinline__ float bf2f(unsigned short b) { return __builtin_bit_cast(float, (unsigned)b << 16); }
__device__ __forceinline__ void store8bf(bf16_t* p, f32x4 a, f32x4 b) {
    u32x4 w; w.x = pk2(a[0], a[1]); w.y = pk2(a[2], a[3]); w.z = pk2(b[0], b[1]); w.w = pk2(b[2], b[3]); *(u32x4*)p = w;
}
__device__ __forceinline__ void load8bf(const bf16_t* p, f32x4& a, f32x4& b) {
    const u32x4 w = *(const u32x4*)p;
    a[0] = __builtin_bit_cast(float, w.x << 16); a[1] = __builtin_bit_cast(float, w.x & 0xffff0000u);
    a[2] = __builtin_bit_cast(float, w.y << 16); a[3] = __builtin_bit_cast(float, w.y & 0xffff0000u);
    b[0] = __builtin_bit_cast(float, w.z << 16); b[1] = __builtin_bit_cast(float, w.z & 0xffff0000u);
    b[2] = __builtin_bit_cast(float, w.w << 16); b[3] = __builtin_bit_cast(float, w.w & 0xffff0000u);
}
__device__ __forceinline__ float sumsq8(f32x4 a, f32x4 b) { return (a[0] * a[0] + a[1] * a[1]) + (a[2] * a[2] + a[3] * a[3]) + (b[0] * b[0] + b[1] * b[1]) + (b[2] * b[2] + b[3] * b[3]); }
__device__ __forceinline__ int rope_logical(int p) { const int i = p & 7, gq = p >> 3; return i < 4 ? 4 * gq + i : 16 + 4 * gq + (i - 4); }
__device__ __forceinline__ int tok_pos(int row) { return row < M_PROMPT ? (row & (SEQ_P - 1)) : row - M_PROMPT; }
__device__ __forceinline__ int perm32(int rho) { const int n = rho >> 4, i = rho & 15; return 8 * (i >> 2) + 4 * n + (i & 3); }
__device__ __forceinline__ float wave_sum(float v) {
#pragma unroll
    for (int o = 1; o < 64; o <<= 1) v += __shfl_xor(v, o);
    return v;
}
__device__ __forceinline__ float gelu_tanh(float x) {
    const float z = 0.7978845608028654f * (x + 0.044715f * x * x * x);
    const float e = __expf(2.f * z);
    const float th = 1.f - 2.f / (1.f + e);
    return 0.5f * x * (1.f + th);
}

struct EpiProj {
    const float* rstd1; bf16_t* proj; bf16_t* ua; const float* cosT; const float* sinT; float* ssq_q; float* ssq_kv;
    __device__ __forceinline__ float* ssq(int pn) const { return pn == 0 ? ssq_q : (pn == 1 ? ssq_kv : nullptr); }
    __device__ __forceinline__ float operator()(int row, int col, f32x4 v0, f32x4 v1) const {
        const float r = rstd1[row]; v0 = v0 * r; v1 = v1 * r;
        if (col < 384) { store8bf(proj + (size_t)row * 512 + col, v0, v1); return sumsq8(v0, v1); }
        if (col < 416) {
            const int pos = tok_pos(row), gq = (col - 384) >> 3;
            const f32x4 c = *(const f32x4*)(cosT + pos * 16 + gq * 4), s = *(const f32x4*)(sinT + pos * 16 + gq * 4);
            const f32x4 o1 = v0 * c - v1 * s, o2 = v1 * c + v0 * s;
            store8bf(proj + (size_t)row * 512 + col, o1, o2); return 0.f;
        }
        if (col < 512) return 0.f;
        const int c2 = col - 512, g = c2 >> 4, h0 = c2 & 15, chunk = row >> 4, t = row & 15;
        store8bf(ua + ((size_t)chunk * 32 + g) * 512 + t * 16 + h0, v0, v1); return 0.f;
    }
};
struct EpiQ {
    const float* ssq_q; bf16_t* q; const float* cosT; const float* sinT;
    __device__ __forceinline__ float* ssq(int) const { return nullptr; }
    __device__ __forceinline__ float operator()(int row, int col, f32x4 v0, f32x4 v1) const {
        const float r = rsqrtf(ssq_q[row] * (1.f / QR) + EPS); v0 = v0 * r; v1 = v1 * r;
        const int d = col % DQK;
        if (d >= DNOPE) {
            const int pos = tok_pos(row), gq = (d - DNOPE) >> 3;
            const f32x4 c = *(const f32x4*)(cosT + pos * 16 + gq * 4), s = *(const f32x4*)(sinT + pos * 16 + gq * 4);
            const f32x4 o1 = v0 * c - v1 * s, o2 = v1 * c + v0 * s; v0 = o1; v1 = o2;
        }
        store8bf(q + (size_t)row * 768 + col, v0 * QSCALE, v1 * QSCALE); return 0.f;
    }
};
struct EpiKV {
    const float* ssq_kv; const bf16_t* proj; bf16_t* k; bf16_t* v;
    __device__ __forceinline__ float* ssq(int) const { return nullptr; }
    __device__ __forceinline__ float operator()(int row, int col, f32x4 v0, f32x4 v1) const {
        const float r = rsqrtf(ssq_kv[row] * (1.f / KVR) + EPS); v0 = v0 * r; v1 = v1 * r;
        const int h = col >> 7, w = col & 127;
        if (w < 64) {
            store8bf(k + (size_t)row * 768 + h * DQK + w, v0, v1);
            if (w < 32) *(u32x4*)(k + (size_t)row * 768 + h * DQK + 64 + w) = *(const u32x4*)(proj + (size_t)row * 512 + 384 + w);
        } else store8bf(v + (size_t)row * 512 + h * DV + (w - 64), v0, v1);
        return 0.f;
    }
};
struct EpiLst {
    float* lst;
    __device__ __forceinline__ float* ssq(int) const { return nullptr; }
    __device__ __forceinline__ float operator()(int row, int col, f32x4 v0, f32x4 v1) const {
        float* o = lst + (size_t)row * 8192 + col; *(f32x4*)o = v0; *(f32x4*)(o + 4) = v1; return 0.f;
    }
};
struct EpiSsmOut {
    bf16_t* g;
    __device__ __forceinline__ float* ssq(int) const { return nullptr; }
    __device__ __forceinline__ float operator()(int row, int col, f32x4 v0, f32x4 v1) const {
        const int grp = col >> 8, t = (col >> 4) & 15, h0 = col & 15;
#pragma unroll
        for (int i = 0; i < 4; ++i) { v0[i] = gelu_tanh(v0[i]); v1[i] = gelu_tanh(v1[i]); }
        store8bf(g + ((size_t)row * 16 + t) * 512 + grp * 16 + h0, v0, v1); return 0.f;
    }
};
struct EpiGlu {
    const bf16_t* g; const float* bias; bf16_t* mix; float* ssq_s;
    __device__ __forceinline__ float* ssq(int) const { return ssq_s; }
    __device__ __forceinline__ float operator()(int row, int col, f32x4 v0, f32x4 v1) const {
        f32x4 g0, g1; load8bf(g + (size_t)row * 512 + col, g0, g1);
        const f32x4 b0 = *(const f32x4*)(bias + col), b1 = *(const f32x4*)(bias + col + 4);
#pragma unroll
        for (int i = 0; i < 4; ++i) { v0[i] = g0[i] / (1.f + __expf(-(v0[i] + b0[i]))); v1[i] = g1[i] / (1.f + __expf(-(v1[i] + b1[i]))); }
        store8bf(mix + (size_t)row * 1024 + 512 + col, v0, v1); return sumsq8(v0, v1);
    }
};
struct EpiOut {
    const float* xp; const float* xs; const float* ssq_s; float* x1; bf16_t* x1b; float* ssq_x1;
    __device__ __forceinline__ float* ssq(int) const { return ssq_x1; }
    __device__ __forceinline__ float operator()(int row, int col, f32x4 v0, f32x4 v1) const {
        const float r = rsqrtf(ssq_s[row] * (1.f / 512) + EPS);
        const float* xr = (row < M_PROMPT ? xp + (size_t)row * DM : xs + (size_t)(row - M_PROMPT) * DM) + col;
        v0 = *(const f32x4*)xr + v0 * r; v1 = *(const f32x4*)(xr + 4) + v1 * r;
        float* o = x1 + (size_t)row * DM + col; *(f32x4*)o = v0; *(f32x4*)(o + 4) = v1;
        store8bf(x1b + (size_t)row * DM + col, v0, v1); return sumsq8(v0, v1);
    }
};
struct EpiMlp1 {
    const float* ssq_x1; bf16_t* hb; int r0, pad;
    __device__ __forceinline__ float* ssq(int) const { return nullptr; }
    __device__ __forceinline__ float operator()(int row, int col, f32x4 v0, f32x4 v1) const {
        const float r = rsqrtf(ssq_x1[r0 + row] * (1.f / DM) + EPS);
#pragma unroll
        for (int i = 0; i < 4; ++i) { float a = fmaxf(v0[i] * r, 0.f), b = fmaxf(v1[i] * r, 0.f); v0[i] = a * a; v1[i] = b * b; }
        store8bf(hb + (size_t)row * DFF + col, v0, v1); return 0.f;
    }
};
struct EpiMlp2 {
    float* x; float* ssq_x2; int r0, pad;
    __device__ __forceinline__ float* ssq(int) const { return ssq_x2; }
    __device__ __forceinline__ float operator()(int row, int col, f32x4 v0, f32x4 v1) const {
        float* o = x + (size_t)row * DM + col;
        v0 = *(const f32x4*)o + v0; v1 = *(const f32x4*)(o + 4) + v1;
        *(f32x4*)o = v0; *(f32x4*)(o + 4) = v1; return sumsq8(v0, v1);
    }
};


namespace pg8 {
constexpr int BM = 256, BK = 64, HALF = 128, HTB = HALF * BK * 2, STAGE_BYTES = 8 * HTB, NXCD = 8, WGM = 8;
__host__ __device__ __forceinline__ int lds_byte(int r, int c) { const int st = (r >> 4) * 2 + (c >> 5), rr = r & 15, cc = c & 31, ob = rr * 64 + cc * 2; return st * 1024 + (ob ^ (((ob >> 9) & 1) << 5)); }
__host__ __device__ __forceinline__ void stage_rc(int b, int& R, int& C) { const int st = b / 1024, sb = b % 1024, swz = sb ^ (((sb >> 9) & 1) << 5); R = (st >> 1) * 16 + swz / 64; C = (st & 1) * 32 + (swz % 64) / 2; }
struct Unit { int pm, pn; };
struct Gemm { const bf16_t* A; const bf16_t* Bt; int M, N, K, lda, ldb, a_pn_off, resc_t; const float* ssa; const float* sss; };
struct StaticOrder {
    int nM, nN, nwg, G, c;
    __device__ void init(int M, int N, int G_, int c_) { nM = M / BM; nN = N / BM; nwg = nM * nN; G = G_; c = c_; }
    __device__ bool next(int i, Unit& u) const {
        const long L = (long)i * G + c; if (L >= nwg) return false;
        int wgid = (int)L; { const int q = nwg / NXCD, r = nwg % NXCD, xcd = wgid % NXCD, off = wgid / NXCD; wgid = (xcd < r ? xcd * (q + 1) : r * (q + 1) + (xcd - r) * q) + off; }
        const int nig = WGM * nN, gid = wgid / nig, fm = gid * WGM, gsz = (nM - fm) < WGM ? (nM - fm) : WGM;
        u.pm = fm + ((wgid % nig) % gsz); u.pn = (wgid % nig) / gsz; return true;
    }
};
template <class E> struct EpiW {
    E e;
    __device__ __forceinline__ void operator()(const f32x4 (&acc)[2][2][4][2], const Unit& u, int wr, int wc, int fr, int fq) const {
        float* tgt = e.ssq(u.pn);
#pragma unroll
        for (int ai = 0; ai < 2; ++ai)
#pragma unroll
            for (int m = 0; m < 4; ++m) {
                int row = u.pm * BM + ai * HALF + wr * 64 + m * 16 + fr; asm volatile("" : "+v"(row)); float s = 0.f;
#pragma unroll
                for (int bj = 0; bj < 2; ++bj) s += e(row, u.pn * BM + bj * HALF + wc * 32 + 8 * fq, acc[ai][bj][m][0], acc[ai][bj][m][1]);
                if (tgt) { s += __shfl_xor(s, 16); s += __shfl_xor(s, 32); if (fq == 0) atomicAdd(tgt + row, s); }
                asm volatile("" ::: "memory");
            }
    }
};
template <class Epi>
__device__ __forceinline__ void gemm_phase(LAS unsigned char* lds, const Gemm g, const StaticOrder& S, const Epi& E) {
    int tid = threadIdx.x; asm volatile("" : "+v"(tid));
    const int wid = __builtin_amdgcn_readfirstlane(tid >> 6), lane = tid & 63, wr = wid >> 2, wc = wid & 3, fr = lane & 15, fq = lane >> 4;
    const int K = g.K, nt = K / BK;
    unsigned voffA[2], voffB[2];
#pragma unroll
    for (int i = 0; i < 2; ++i) { int R, C; stage_rc(tid * 16 + i * 8192, R, C); const int Rb = (R & ~31) + perm32(R & 31);
        voffA[i] = (unsigned)(R * g.lda + C) * 2u; voffB[i] = (unsigned)(Rb * g.ldb + C) * 2u; }
    const size_t kstep = (size_t)(BK * 2);
    const size_t hstepA = (size_t)HALF * g.lda * 2, hstepB = (size_t)HALF * g.ldb * 2;
    const size_t tstepA = 2 * hstepA, tstepB = 2 * hstepB, pstepA = (size_t)g.a_pn_off * 2;
    const unsigned ldsw = (unsigned)wid * 1024u;
    const int aoff = lds_byte(wr * 64 + fr, fq * 8), boff = lds_byte(wc * 32 + fr, fq * 8);
#define PG8_SA(b, h) (((b) * 2 + (h)) * HTB)
#define PG8_SB(b, h) ((4 + (b) * 2 + (h)) * HTB)
#define PG8_STAGE(bufoff, gbase, voff) do { _Pragma("unroll") for (int _i = 0; _i < 2; ++_i) \
        __builtin_amdgcn_global_load_lds((const unsigned*)((const char*)(gbase) + (voff)[_i]), (LAS unsigned*)(lds + (bufoff) + ldsw + _i * 8192), 16, 0, 0); } while (0)
#define PG8_LDA(dst, b, h) do { _Pragma("unroll") for (int m = 0; m < 4; ++m) _Pragma("unroll") for (int k = 0; k < 2; ++k) dst[m][k] = *(const LAS bf16x8*)(lds + PG8_SA(b, h) + aoff + m * 2048 + k * 1024); } while (0)
#define PG8_LDB(dst, b, h) do { _Pragma("unroll") for (int n = 0; n < 2; ++n) _Pragma("unroll") for (int k = 0; k < 2; ++k) dst[n][k] = *(const LAS bf16x8*)(lds + PG8_SB(b, h) + boff + n * 2048 + k * 1024); } while (0)
#define PG8_MMA(ai, bj, At, Bt) do { __builtin_amdgcn_s_setprio(1); _Pragma("unroll") for (int m = 0; m < 4; ++m) _Pragma("unroll") for (int n = 0; n < 2; ++n) _Pragma("unroll") for (int k = 0; k < 2; ++k) \
        acc[ai][bj][m][n] = __builtin_amdgcn_mfma_f32_16x16x32_bf16(Bt[n][k], At[m][k], acc[ai][bj][m][n], 0, 0, 0); __builtin_amdgcn_s_setprio(0); } while (0)
#define PG8_WAIT_V(n) asm volatile("s_waitcnt vmcnt(" #n ")" ::: "memory")
#define PG8_WAIT_L(n) asm volatile("s_waitcnt lgkmcnt(" #n ")" ::: "memory")
#define PG8_BAR __builtin_amdgcn_s_barrier()
#define PG8_SCHED __builtin_amdgcn_sched_barrier(0)
    Unit cur, nxt; int ui = 0;
    if (!S.next(0, cur)) return;
    f32x4 acc[2][2][4][2];
#pragma unroll
    for (int a = 0; a < 2; ++a)
#pragma unroll
        for (int b = 0; b < 2; ++b)
#pragma unroll
            for (int m = 0; m < 4; ++m)
#pragma unroll
                for (int n = 0; n < 2; ++n) acc[a][b][m][n] = (f32x4){0.f, 0.f, 0.f, 0.f};
    bf16x8 At[4][2], B0[2][2], B1[2][2];
    const char* cA = (const char*)g.A + (size_t)cur.pm * tstepA + (size_t)cur.pn * pstepA; const char* cB = (const char*)g.Bt + (size_t)cur.pn * tstepB;
    PG8_STAGE(PG8_SB(0, 0), cB, voffB); PG8_STAGE(PG8_SB(0, 1), cB + hstepB, voffB); PG8_STAGE(PG8_SA(0, 0), cA, voffA); PG8_STAGE(PG8_SA(0, 1), cA + hstepA, voffA);
    if (wr == 1) PG8_BAR;
    PG8_WAIT_V(2); PG8_BAR;
    PG8_STAGE(PG8_SB(1, 0), cB + kstep, voffB); PG8_STAGE(PG8_SA(1, 0), cA + kstep, voffA); PG8_STAGE(PG8_SB(1, 1), cB + hstepB + kstep, voffB);
    PG8_WAIT_V(6); PG8_BAR;
    for (;;) {
        const bool has_next = S.next(ui + 1, nxt);
        const char* nA = has_next ? (const char*)g.A + (size_t)nxt.pm * tstepA + (size_t)nxt.pn * pstepA : cA; const char* nB = has_next ? (const char*)g.Bt + (size_t)nxt.pn * tstepB : cB;
        for (int t = 0; t < nt; t += 2) {
            const bool last = (t == nt - 2);
            const char* a1 = cA + (size_t)(t + 1) * kstep;
            const char* a2 = last ? nA : cA + (size_t)(t + 2) * kstep; const char* b2 = last ? nB : cB + (size_t)(t + 2) * kstep;
            const char* a3 = a2 + kstep; const char* b3 = b2 + kstep;
            if (t == g.resc_t) {
#pragma unroll
                for (int ai = 0; ai < 2; ++ai)
#pragma unroll
                    for (int m = 0; m < 4; ++m) { int row = cur.pm * BM + ai * HALF + wr * 64 + m * 16 + fr; asm volatile("" : "+v"(row));
                        const float f = sqrtf((g.sss[row] * (1.f / 512) + EPS) / (g.ssa[row] * (1.f / 512) + EPS));
#pragma unroll
                        for (int bj = 0; bj < 2; ++bj) { acc[ai][bj][m][0] = acc[ai][bj][m][0] * f; acc[ai][bj][m][1] = acc[ai][bj][m][1] * f; }
                        asm volatile("" ::: "memory"); }
            }
            PG8_LDB(B0, 0, 0); PG8_LDB(B1, 0, 1); PG8_SCHED; PG8_LDA(At, 0, 0); PG8_STAGE(PG8_SA(1, 1), a1 + hstepA, voffA);
            PG8_WAIT_V(8); PG8_WAIT_L(0); PG8_BAR; PG8_MMA(0, 0, At, B0); PG8_MMA(0, 1, At, B1); PG8_BAR; PG8_SCHED;
            PG8_LDA(At, 0, 1); PG8_STAGE(PG8_SB(0, 0), b2, voffB); PG8_STAGE(PG8_SB(0, 1), b2 + hstepB, voffB); PG8_STAGE(PG8_SA(0, 0), a2, voffA);
            PG8_WAIT_V(8); PG8_WAIT_L(0); PG8_BAR; PG8_MMA(1, 0, At, B0); PG8_MMA(1, 1, At, B1); PG8_BAR; PG8_SCHED;
            PG8_LDB(B0, 1, 0); PG8_LDB(B1, 1, 1); PG8_SCHED; PG8_LDA(At, 1, 0); PG8_STAGE(PG8_SA(0, 1), a2 + hstepA, voffA);
            PG8_WAIT_V(8); PG8_WAIT_L(0); PG8_BAR; PG8_MMA(0, 0, At, B0); PG8_MMA(0, 1, At, B1); PG8_BAR; PG8_SCHED;
            PG8_LDA(At, 1, 1); PG8_STAGE(PG8_SB(1, 0), b3, voffB); PG8_STAGE(PG8_SB(1, 1), b3 + hstepB, voffB); PG8_STAGE(PG8_SA(1, 0), a3, voffA);
            PG8_WAIT_V(8); PG8_WAIT_L(0); PG8_BAR; PG8_MMA(1, 0, At, B0); PG8_MMA(1, 1, At, B1); PG8_BAR; PG8_SCHED;
        }
        if (wr == 0) PG8_BAR;
        E(acc, cur, wr, wc, fr, fq);
        if (!has_next) break;
#pragma unroll
        for (int a = 0; a < 2; ++a)
#pragma unroll
            for (int b = 0; b < 2; ++b)
#pragma unroll
                for (int m = 0; m < 4; ++m)
#pragma unroll
                    for (int n = 0; n < 2; ++n) acc[a][b][m][n] = (f32x4){0.f, 0.f, 0.f, 0.f};
        cur = nxt; cA = nA; cB = nB; ++ui;
        if (wr == 1) PG8_BAR;
    }
    PG8_WAIT_V(0);
    PG8_BAR;
#undef PG8_SA
#undef PG8_SB
#undef PG8_STAGE
#undef PG8_LDA
#undef PG8_LDB
#undef PG8_MMA
#undef PG8_WAIT_V
#undef PG8_WAIT_L
#undef PG8_BAR
#undef PG8_SCHED
}
template <class E>
__device__ __forceinline__ void run_gemm(LAS unsigned char* lds, const bf16_t* A, int lda, int a_pn_off, const bf16_t* Bt, int ldb, int M, int N, int K, const E& e, int G, int bx,
                                         int resc_t = -1, const float* ssa = nullptr, const float* sss = nullptr) {
    Gemm g{A, Bt, M, N, K, lda, ldb, a_pn_off, resc_t, ssa, sss};
    StaticOrder S; S.init(M, N, G, bx);
    EpiW<E> W{e};
    gemm_phase<EpiW<E>>(lds, g, S, W);
}
}

template <class E>
__global__ __launch_bounds__(256) void naive_gemm(const bf16_t* A, int lda, int a_pn_off, const bf16_t* Bt, int ldb, int M, int N, int K, E e, int resc_k, const float* ssa, const float* sss) {
    const int lane = threadIdx.x & 63, wid = threadIdx.x >> 6, fr = lane & 15, fq = lane >> 4;
    const int nct = N / 32, ntask = (M / 64) * nct;
    for (int task = blockIdx.x * 4 + wid; task < ntask; task += gridDim.x * 4) {
        const int rt = task / nct, ct = task % nct, pn = (ct * 32) >> 8;
        const bf16_t* Ab = A + (size_t)pn * a_pn_off + (size_t)(rt * 64 + fr) * lda + fq * 8;
        const bf16_t* Wb0 = Bt + (size_t)(ct * 32 + perm32(fr)) * ldb + fq * 8;
        const bf16_t* Wb1 = Bt + (size_t)(ct * 32 + perm32(16 + fr)) * ldb + fq * 8;
        f32x4 acc[4][2];
#pragma unroll
        for (int m = 0; m < 4; ++m) { acc[m][0] = (f32x4){0, 0, 0, 0}; acc[m][1] = (f32x4){0, 0, 0, 0}; }
        for (int k0 = 0; k0 < K; k0 += 32) {
            if (k0 == resc_k) {
#pragma unroll
                for (int m = 0; m < 4; ++m) { const int row = rt * 64 + m * 16 + fr; const float f = sqrtf((sss[row] * (1.f / 512) + EPS) / (ssa[row] * (1.f / 512) + EPS)); acc[m][0] = acc[m][0] * f; acc[m][1] = acc[m][1] * f; }
            }
            const bf16x8 w0 = *(const bf16x8*)(Wb0 + k0), w1 = *(const bf16x8*)(Wb1 + k0);
#pragma unroll
            for (int m = 0; m < 4; ++m) {
                const bf16x8 a = *(const bf16x8*)(Ab + (size_t)m * 16 * lda + k0);
                acc[m][0] = __builtin_amdgcn_mfma_f32_16x16x32_bf16(w0, a, acc[m][0], 0, 0, 0);
                acc[m][1] = __builtin_amdgcn_mfma_f32_16x16x32_bf16(w1, a, acc[m][1], 0, 0, 0);
            }
        }
        float* tgt = e.ssq(pn);
#pragma unroll
        for (int m = 0; m < 4; ++m) {
            const int row = rt * 64 + m * 16 + fr;
            float s = e(row, ct * 32 + 8 * fq, acc[m][0], acc[m][1]);
            if (tgt) { s += __shfl_xor(s, 16); s += __shfl_xor(s, 32); if (fq == 0) atomicAdd(tgt + row, s); }
        }
    }
}

__global__ __launch_bounds__(256) void naive_attn(const bf16_t* __restrict__ Q, const bf16_t* __restrict__ K, const bf16_t* __restrict__ V, bf16_t* __restrict__ mix, float* __restrict__ ssq_a) {
    const int h = blockIdx.y, row = blockIdx.x * 256 + threadIdx.x;
    const int s0 = row < M_PROMPT ? (blockIdx.x * 256 / SEQ_P) * SEQ_P : M_PROMPT, len = row < M_PROMPT ? SEQ_P : SEQ_S;
    float q[DQK], o[DV];
#pragma unroll
    for (int d = 0; d < DQK; ++d) q[d] = bf2f(Q[(size_t)row * 768 + h * DQK + d]);
#pragma unroll
    for (int d = 0; d < DV; ++d) o[d] = 0.f;
    float m = -1e30f, l = 0.f;
    for (int j = 0; j < len; ++j) {
        const bf16_t* kp = K + (size_t)(s0 + j) * 768 + h * DQK; const bf16_t* vp = V + (size_t)(s0 + j) * 512 + h * DV;
        float s = 0.f;
#pragma unroll
        for (int d = 0; d < DQK; ++d) s += q[d] * bf2f(kp[d]);
        if (s > m) { const float a = exp2f(m - s); l *= a;
#pragma unroll
            for (int d = 0; d < DV; ++d) o[d] *= a;
            m = s; }
        const float p = exp2f(s - m); l += p;
#pragma unroll
        for (int d = 0; d < DV; ++d) o[d] += p * bf2f(vp[d]);
    }
    const float il = 1.f / l; float ss = 0.f;
#pragma unroll
    for (int d = 0; d < DV; ++d) { o[d] *= il; ss += o[d] * o[d]; }
#pragma unroll
    for (int d = 0; d < DV; d += 2) *(unsigned*)(mix + (size_t)row * 1024 + h * DV + d) = pk2(o[d], o[d + 1]);
    atomicAdd(ssq_a + row, ss);
}

__global__ __launch_bounds__(64) void naive_ssm(const bf16_t* __restrict__ ua, float* __restrict__ Y, int dir, const float* lam_re, const float* lam_im, const float* log_dt,
                                                const float* b_re, const float* b_im, const float* c_re, const float* c_im, const float* d_skip) {
    const int n = threadIdx.x, g = blockIdx.x & 31, sq = blockIdx.x >> 5;
    const int s0 = sq < 8 ? sq * SEQ_P : M_PROMPT, len = sq < 8 ? SEQ_P : SEQ_S;
    const int pi = (dir * NG + g) * NS + n;
    const float lr = lam_re[pi], li = lam_im[pi], dt = expf(log_dt[dir * NG + g]);
    const float mag = expf(lr * dt); float sn, cs; sincosf(li * dt, &sn, &cs);
    const float ar = mag * cs, ai = mag * sn;
    const float nr = ar - 1.f, ni = ai, den = lr * lr + li * li;
    const float fr_ = (nr * lr + ni * li) / den, fi_ = (ni * lr - nr * li) / den;
    float bbr[GH], bbi[GH], cr[GH], ci[GH];
#pragma unroll
    for (int h = 0; h < GH; ++h) {
        const float br = b_re[(size_t)pi * GH + h], bi = b_im[(size_t)pi * GH + h];
        bbr[h] = fr_ * br - fi_ * bi; bbi[h] = fr_ * bi + fi_ * br;
        cr[h] = c_re[((size_t)(dir * NG + g) * GH + h) * NS + n]; ci[h] = c_im[((size_t)(dir * NG + g) * GH + h) * NS + n];
    }
    const int hsel = ((n >> 5) & 1) * 8 + ((n >> 4) & 1) * 4 + ((n >> 3) & 1) * 2 + ((n >> 2) & 1);
    float xr = 0.f, xi = 0.f;
    const int nch = len / CT, c0 = s0 / CT;
    for (int cc = 0; cc < nch; ++cc) {
        const int chunk = c0 + (dir == 0 ? cc : nch - 1 - cc);
        const u32x2 raw = *(const u32x2*)(ua + ((size_t)chunk * 32 + g) * 512 + n * 4);
        float uv[4]; uv[0] = __builtin_bit_cast(float, raw.x << 16); uv[1] = __builtin_bit_cast(float, raw.x & 0xffff0000u);
        uv[2] = __builtin_bit_cast(float, raw.y << 16); uv[3] = __builtin_bit_cast(float, raw.y & 0xffff0000u);
#pragma unroll
        for (int tt = 0; tt < CT; ++tt) {
            const int t = dir == 0 ? tt : CT - 1 - tt;
            float u[GH];
#pragma unroll
            for (int h = 0; h < GH; ++h) u[h] = __shfl(uv[h & 3], t * 4 + (h >> 2));
            float bur = 0.f, bui = 0.f;
#pragma unroll
            for (int h = 0; h < GH; ++h) { bur += bbr[h] * u[h]; bui += bbi[h] * u[h]; }
            const float nxr = ar * xr - ai * xi + bur, nxi = ar * xi + ai * xr + bui; xr = nxr; xi = nxi;
            float v[GH];
#pragma unroll
            for (int h = 0; h < GH; ++h) v[h] = cr[h] * xr - ci[h] * xi;
#pragma unroll
            for (int i = 0; i < 8; ++i) { const bool up = n & 32; const float send = up ? v[i] : v[i + 8], keep = up ? v[i + 8] : v[i]; v[i] = keep + __shfl_xor(send, 32); }
#pragma unroll
            for (int i = 0; i < 4; ++i) { const bool up = n & 16; const float send = up ? v[i] : v[i + 4], keep = up ? v[i + 4] : v[i]; v[i] = keep + __shfl_xor(send, 16); }
#pragma unroll
            for (int i = 0; i < 2; ++i) { const bool up = n & 8; const float send = up ? v[i] : v[i + 2], keep = up ? v[i + 2] : v[i]; v[i] = keep + __shfl_xor(send, 8); }
            { const bool up = n & 4; const float send = up ? v[0] : v[1], keep = up ? v[1] : v[0]; v[0] = keep + __shfl_xor(send, 4); }
            v[0] += __shfl_xor(v[0], 2); v[0] += __shfl_xor(v[0], 1);
            if ((n & 3) == 0) {
                float* yp = Y + (size_t)(chunk * CT + t) * SSMW + g * GH + hsel;
                if (dir == 0) *yp = v[0]; else *yp += v[0];
            }
        }
    }
}
__global__ __launch_bounds__(256) void naive_ssm_finish(const float* __restrict__ Y, const bf16_t* __restrict__ ua, const float* __restrict__ d_skip, bf16_t* __restrict__ G) {
    const size_t i = (size_t)blockIdx.x * 256 + threadIdx.x;
    if (i < (size_t)M_TOK * SSMW) {
        const int row = (int)(i >> 9), col = (int)(i & 511), g = col >> 4, h = col & 15;
        const float u = bf2f(ua[((size_t)(row >> 4) * 32 + g) * 512 + (row & 15) * 16 + h]);
        G[i] = (bf16_t)f2bf(gelu_tanh(Y[i] + d_skip[col] * u));
    }
}

__device__ __forceinline__ void final_norm_rows(float* out, const float* ssq_x2, const float* fg, int gw, int ngw, int lane) {
    for (int m = gw; m < M_TOK; m += ngw) {
        const float r = rsqrtf(ssq_x2[m] * (1.f / DM) + EPS);
        f32x4* o = (f32x4*)(out + (size_t)m * DM) + lane;
#pragma unroll
        for (int j = 0; j < 4; ++j) { const f32x4 g = *((const f32x4*)fg + lane + 64 * j); o[64 * j] = o[64 * j] * r * g; }
    }
}
__global__ __launch_bounds__(256) void naive_final(float* out, const float* ssq_x2, const float* fg) {
    final_norm_rows(out, ssq_x2, fg, blockIdx.x * 4 + (threadIdx.x >> 6), gridDim.x * 4, threadIdx.x & 63);
}

constexpr int NWAVES = 8;
template <class MAP>
__device__ __forceinline__ void transpose_item(const float* W, int K, int N, bf16_t* WT, LAS float* scr, int item, int lane, int nblk, const MAP& map, const float* gain0, const float* gain1, int gsplit) {
    const int kb = item / nblk, nb = item % nblk, k0 = 64 * kb, n0 = 32 * nb;
    const int sc = map(n0 + (lane & 31));
#pragma unroll 8
    for (int i = 0; i < 32; ++i) {
        const int kk = 2 * i + (lane >> 5), k = k0 + kk;
        float v = sc >= 0 ? W[(size_t)k * N + sc] : 0.f;
        if (gain0) v *= (k < gsplit ? gain0[k] : gain1[k - gsplit]);
        scr[kk * 33 + (lane & 31)] = v;
    }
    asm volatile("s_waitcnt lgkmcnt(0)" ::: "memory");
    const int c = lane & 7;
#pragma unroll
    for (int j = 0; j < 4; ++j) {
        const int n = (lane >> 3) + 8 * j; const LAS float* s = scr + (8 * c) * 33 + n;
        u32x4 o; o.x = pk2(s[0 * 33], s[1 * 33]); o.y = pk2(s[2 * 33], s[3 * 33]); o.z = pk2(s[4 * 33], s[5 * 33]); o.w = pk2(s[6 * 33], s[7 * 33]);
        *(u32x4*)(WT + (size_t)(n0 + n) * K + k0 + 8 * c) = o;
    }
    asm volatile("s_waitcnt lgkmcnt(0)" ::: "memory");
}
struct MapId { __device__ __forceinline__ int operator()(int n) const { return n; } };
struct MapWin { __device__ __forceinline__ int operator()(int n) const { if (n < 384) return n; if (n < 416) return 384 + rope_logical(n - 384); if (n < 512) return -1; return 416 + (n - 512); } };
struct MapWuq { __device__ __forceinline__ int operator()(int n) const { const int h = n / DQK, d = n % DQK; return h * DQK + (d < DNOPE ? d : DNOPE + rope_logical(d - DNOPE)); } };

struct cpx { float r, i; };
__device__ __forceinline__ cpx cmul(cpx a, cpx b) { return {a.r * b.r - a.i * b.i, a.r * b.i + a.i * b.r}; }
__device__ __forceinline__ cpx apow(float lr, float li, float dt, float p) { const float mag = expf(lr * dt * p); float sn, cs; sincosf(li * dt * p, &sn, &cs); return {mag * cs, mag * sn}; }
__device__ __forceinline__ cpx bfac(float lr, float li, float dt) {
    const cpx a = apow(lr, li, dt, 1.f); const float nr = a.r - 1.f, ni = a.i, den = lr * lr + li * li;
    return {(nr * lr + ni * li) / den, (ni * lr - nr * li) / den};
}

__device__ __forceinline__ void prologue(const Params& p, LAS unsigned char* lds, int vcu, int G) {
    const int tid = threadIdx.x, lane = tid & 63, wave = tid >> 6;
    const int gw = vcu * NWAVES + wave, NGW = G * NWAVES;
    unsigned char* ws = p.ws;
    LAS float* scr = (LAS float*)(lds + wave * 16384);
    {
        constexpr int I_WIN = 16 * 32, I_WUQ = 4 * 24, I_WUKV = 2 * 32, I_WGLU = 8 * 16, I_WOUT = 16 * 32, I_W1 = 16 * 128, I_W2 = 64 * 32;
        constexpr int NITEMS = I_WIN + I_WUQ + I_WUKV + I_WGLU + I_WOUT + I_W1 + I_W2;
        for (int it = gw; it < NITEMS; it += NGW) {
            int r = it;
            if (r < I_WIN) { transpose_item(p.in[3], 1024, INW, (bf16_t*)(ws + WS_WIN), scr, r, lane, 32, MapWin(), p.in[2], p.in[2], 1 << 30); continue; } r -= I_WIN;
            if (r < I_WUQ) { transpose_item(p.in[5], 256, 768, (bf16_t*)(ws + WS_WUQ), scr, r, lane, 24, MapWuq(), p.in[4], p.in[4], 1 << 30); continue; } r -= I_WUQ;
            if (r < I_WUKV) { transpose_item(p.in[7], 128, 1024, (bf16_t*)(ws + WS_WUKV), scr, r, lane, 32, MapId(), p.in[6], p.in[6], 1 << 30); continue; } r -= I_WUKV;
            if (r < I_WGLU) { transpose_item(p.in[16], 512, 512, (bf16_t*)(ws + WS_WGLU), scr, r, lane, 16, MapId(), nullptr, nullptr, 0); continue; } r -= I_WGLU;
            if (r < I_WOUT) { transpose_item(p.in[20], 1024, 1024, (bf16_t*)(ws + WS_WOUT), scr, r, lane, 32, MapId(), p.in[18], p.in[19], 512); continue; } r -= I_WOUT;
            if (r < I_W1) { transpose_item(p.in[22], 1024, 4096, (bf16_t*)(ws + WS_W1), scr, r, lane, 128, MapId(), p.in[21], p.in[21], 1 << 30); continue; } r -= I_W1;
            transpose_item(p.in[23], 4096, 1024, (bf16_t*)(ws + WS_W2), scr, r, lane, 32, MapId(), nullptr, nullptr, 0);
        }
    }
    {
        float* stat = (float*)(ws + WS_STAT); bf16_t* xb = (bf16_t*)(ws + WS_XB);
        for (int m = gw; m < M_TOK; m += NGW) {
            const float* xrow = m < M_PROMPT ? p.in[0] + (size_t)m * DM : p.in[1] + (size_t)(m - M_PROMPT) * DM;
            const f32x4* xr = (const f32x4*)xrow + lane;
            f32x4 v[4]; float s = 0.f;
#pragma unroll
            for (int j = 0; j < 4; ++j) { v[j] = xr[64 * j]; s += (v[j].x * v[j].x + v[j].y * v[j].y) + (v[j].z * v[j].z + v[j].w * v[j].w); }
            s = wave_sum(s);
            unsigned long long* o8 = (unsigned long long*)(xb + (size_t)m * DM) + lane;
#pragma unroll
            for (int j = 0; j < 4; ++j) o8[64 * j] = (unsigned long long)pk2(v[j].x, v[j].y) | ((unsigned long long)pk2(v[j].z, v[j].w) << 32);
            if (lane == 0) stat[ST_RSTD1 * M_TOK + m] = rsqrtf(s * (1.f / DM) + EPS);
            else if (lane < 7) stat[lane * M_TOK + m] = 0.f;
        }
    }
    {
        float* cosT = (float*)(ws + WS_ROPE); float* sinT = cosT + SEQ_S * 16;
        for (int i = gw * 64 + lane; i < SEQ_S * 16; i += NGW * 64) {
            const int pos = i >> 4, j = i & 15;
            const float inv = powf(10000.f, -(float)(2 * j) / 32.f);
            const float ang = (float)pos * inv; float sn, cs; sincosf(ang, &sn, &cs);
            cosT[i] = cs; sinT[i] = sn;
        }
    }
    {
        const float* lam_re = p.in[8]; const float* lam_im = p.in[9]; const float* log_dt = p.in[10];
        const float* b_re = p.in[11]; const float* b_im = p.in[12]; const float* c_re = p.in[13]; const float* c_im = p.in[14]; const float* d_skip = p.in[15];
        bf16_t* MQ = (bf16_t*)(ws + WS_MQ); bf16_t* SP = (bf16_t*)(ws + WS_SP); float* AT = (float*)(ws + WS_AT);
        for (int it = gw; it < NG * CT * 2; it += NGW) {
            const int dir = it & 1, k = (it >> 1) & 15, g = it >> 5;
            if (k == 0 && dir == 1) continue;
            const int h = lane >> 2, hp0 = (lane & 3) * 4;
            float e[4] = {0.f, 0.f, 0.f, 0.f};
            const int ndir = (k == 0) ? 2 : 1;
            for (int dd = 0; dd < ndir; ++dd) {
                const int d = (k == 0) ? dd : dir;
                const int pi = (d * NG + g) * NS + lane;
                const float lr = lam_re[pi], li = lam_im[pi], dt = expf(log_dt[d * NG + g]);
                const cpx coef = cmul(apow(lr, li, dt, (float)k), bfac(lr, li, dt));
                for (int n = 0; n < NS; ++n) {
                    const cpx cf = {__shfl(coef.r, n), __shfl(coef.i, n)};
                    const size_t ci_ = ((size_t)(d * NG + g) * GH + h) * NS + n;
                    const cpx cc = cmul({c_re[ci_], c_im[ci_]}, cf);
                    const size_t bi_ = ((size_t)(d * NG + g) * NS + n) * GH + hp0;
#pragma unroll
                    for (int q = 0; q < 4; ++q) e[q] += cc.r * b_re[bi_ + q] - cc.i * b_im[bi_ + q];
                }
            }
            if (k == 0) {
#pragma unroll
                for (int q = 0; q < 4; ++q) if (hp0 + q == h) e[q] += d_skip[g * GH + h];
            }
            const unsigned long long w = (unsigned long long)pk2(e[0], e[1]) | ((unsigned long long)pk2(e[2], e[3]) << 32);
            for (int t = 0; t < CT; ++t) {
                const int j = (k == 0) ? t : (dir == 0 ? t - k : t + k);
                if (j < 0 || j >= CT) continue;
                *(unsigned long long*)(MQ + ((size_t)g * 256 + t * 16 + h) * 512 + j * 16 + hp0) = w;
            }
        }
        for (int i = gw * 64 + lane; i < NG * 256 * 256; i += NGW * 64) {
            const int s = i & 255, rr = (i >> 8) & 255, g = i >> 16;
            const int dir = s >> 7, part = (s >> 6) & 1, n = s & 63;
            const int pi = (dir * NG + g) * NS + n;
            const float lr = lam_re[pi], li = lam_im[pi], dt = expf(log_dt[dir * NG + g]);
            {
                const int t = rr >> 4, h = rr & 15;
                const cpx a = apow(lr, li, dt, (float)(dir == 0 ? t + 1 : CT - t));
                const size_t ci_ = ((size_t)(dir * NG + g) * GH + h) * NS + n;
                const cpx v = cmul({c_re[ci_], c_im[ci_]}, a);
                MQ[((size_t)g * 256 + rr) * 512 + 256 + s] = (bf16_t)f2bf(part == 0 ? v.r : -v.i);
            }
            {
                const int j = rr >> 4, hp = rr & 15;
                const cpx a = cmul(apow(lr, li, dt, (float)(dir == 0 ? CT - 1 - j : j)), bfac(lr, li, dt));
                const size_t bi_ = ((size_t)(dir * NG + g) * NS + n) * GH + hp;
                const cpx v = cmul(a, {b_re[bi_], b_im[bi_]});
                SP[((size_t)g * 256 + s) * 256 + rr] = (bf16_t)f2bf(part == 0 ? v.r : v.i);
            }
        }
        for (int i = gw * 64 + lane; i < 2 * NG * NS; i += NGW * 64) {
            const float lr = lam_re[i], li = lam_im[i], dt = expf(log_dt[i >> 6]);
            const cpx a = apow(lr, li, dt, (float)CT); AT[2 * i] = a.r; AT[2 * i + 1] = a.i;
        }
    }
}


namespace att {
using s16x4 = __attribute__((ext_vector_type(4))) short;
using f32x16 = __attribute__((ext_vector_type(16))) float;
constexpr int QBLK = 32, KVBLK = 64;
constexpr int SHM_V = KVBLK * DV * 2, SHM_K = KVBLK * 256;
constexpr int OFF_V = 0, OFF_K = 2 * SHM_V, OFF_WS = 2 * SHM_V + 2 * SHM_K;
constexpr float THRL = 8.f;
#define KSWZ(row, colB) ((row) * 256 + ((colB) ^ (((row) & 7) << 4)))
#define SBAR() __builtin_amdgcn_sched_barrier(0)
__device__ __forceinline__ int crow(int r, int hi) { return (r & 3) + 8 * (r >> 2) + 4 * hi; }
__device__ __forceinline__ unsigned cvtpk(float lo, float hi) { unsigned r; asm volatile("v_cvt_pk_bf16_f32 %0, %1, %2" : "=v"(r) : "v"(lo), "v"(hi)); return r; }
__device__ __forceinline__ void partialSM(f32x16& p0, f32x16& p1, float& m_reg, float& alpha) {
    float pmax = p0[0];
#pragma unroll
    for (int r = 1; r < 16; ++r) pmax = fmaxf(pmax, p0[r]);
#pragma unroll
    for (int r = 0; r < 16; ++r) pmax = fmaxf(pmax, p1[r]);
    { auto rr = __builtin_amdgcn_permlane32_swap(__float_as_uint(pmax), __float_as_uint(pmax), false, false); pmax = fmaxf(__uint_as_float(rr[0]), __uint_as_float(rr[1])); }
    float mn;
    if (__builtin_expect(__all(pmax - m_reg <= THRL), 1)) { mn = m_reg; alpha = 1.f; }
    else { mn = fmaxf(m_reg, pmax); alpha = __builtin_amdgcn_exp2f(m_reg - mn); m_reg = mn; }
#pragma unroll
    for (int r = 0; r < 16; ++r) { p0[r] -= mn; p1[r] -= mn; }
#pragma unroll
    for (int r = 0; r < 16; ++r) p0[r] = __builtin_amdgcn_exp2f(p0[r]);
}
__device__ __forceinline__ void finishSM(f32x16& p0, f32x16& p1, float alpha, float& l_reg, bf16x8& pa0, bf16x8& pa1, bf16x8& pa2, bf16x8& pa3) {
#pragma unroll
    for (int r = 0; r < 16; ++r) p1[r] = __builtin_amdgcn_exp2f(p1[r]);
    float ps = 0;
#pragma unroll
    for (int r = 0; r < 16; ++r) ps += p0[r];
#pragma unroll
    for (int r = 0; r < 16; ++r) ps += p1[r];
    { auto rr = __builtin_amdgcn_permlane32_swap(__float_as_uint(ps), __float_as_uint(ps), false, false); ps = __uint_as_float(rr[0]) + __uint_as_float(rr[1]); }
    l_reg = l_reg * alpha + ps;
#define PK4(P, BASE, OUT) do { unsigned a0 = cvtpk(P[BASE + 0], P[BASE + 1]), a1 = cvtpk(P[BASE + 2], P[BASE + 3]);   \
    unsigned b0 = cvtpk(P[BASE + 4], P[BASE + 5]), b1 = cvtpk(P[BASE + 6], P[BASE + 7]);                              \
    auto r0 = __builtin_amdgcn_permlane32_swap(a0, b0, false, false); auto r1 = __builtin_amdgcn_permlane32_swap(a1, b1, false, false); \
    u32x4 w = {r0[0], r1[0], r0[1], r1[1]}; OUT = __builtin_bit_cast(bf16x8, w); } while (0)
    PK4(p0, 0, pa0); PK4(p0, 8, pa1); PK4(p1, 0, pa2); PK4(p1, 8, pa3);
#undef PK4
}
__device__ __forceinline__ void qkt(f32x16& p0, f32x16& p1, const LAS unsigned char* Ks, const bf16x8* qr, int r32, int hi) {
    p0 = f32x16{}; p1 = f32x16{};
#pragma unroll
    for (int d0 = 0; d0 < DQK / 16; ++d0) { const int cb = (d0 * 16 + hi * 8) * 2;
        const bf16x8 b0 = *(const LAS bf16x8*)(Ks + KSWZ(r32, cb));
        const bf16x8 b1 = *(const LAS bf16x8*)(Ks + KSWZ(32 + r32, cb));
        p0 = __builtin_amdgcn_mfma_f32_32x32x16_bf16(b0, qr[d0], p0, 0, 0, 0);
        p1 = __builtin_amdgcn_mfma_f32_32x32x16_bf16(b1, qr[d0], p1, 0, 0, 0); }
}
__device__ __forceinline__ int v_st(int k, int c) { const int kk = (k & ~0xC) | ((k & 4) << 1) | ((k & 8) >> 1); return ((kk >> 3) * 2 + (c >> 5)) * 512 + ((kk & 7) * 32 + (c & 31)) * 2; }
__device__ __forceinline__ int v_rd_base(int lane) { return ((lane & 3) << 3) | (((lane >> 2) & 3) << 6) | (((lane >> 4) & 1) << 5) | (((lane >> 5) & 1) << 8); }
constexpr int v_rd_off(int d0, int ks, int half) { return d0 * 512 + ks * 2048 + half * 1024; }
template <int OFF> __device__ __forceinline__ s16x4 tr_read(int vb) { s16x4 r; asm volatile("ds_read_b64_tr_b16 %0, %1 offset:%2" : "=&v"(r) : "v"(vb), "i"(OFF) : "memory"); return r; }
template <int D0> __device__ __forceinline__ void pv_one(f32x16& od, int vb, bf16x8 pa0, bf16x8 pa1, bf16x8 pa2, bf16x8 pa3) {
    const s16x4 l0 = tr_read<v_rd_off(D0, 0, 0)>(vb), h0 = tr_read<v_rd_off(D0, 0, 1)>(vb), l1 = tr_read<v_rd_off(D0, 1, 0)>(vb), h1 = tr_read<v_rd_off(D0, 1, 1)>(vb);
    const s16x4 l2 = tr_read<v_rd_off(D0, 2, 0)>(vb), h2 = tr_read<v_rd_off(D0, 2, 1)>(vb), l3 = tr_read<v_rd_off(D0, 3, 0)>(vb), h3 = tr_read<v_rd_off(D0, 3, 1)>(vb);
    asm volatile("s_waitcnt lgkmcnt(0)" ::: "memory"); SBAR();
#define PK(L, H) (bf16x8){L[0], L[1], L[2], L[3], H[0], H[1], H[2], H[3]}
    od = __builtin_amdgcn_mfma_f32_32x32x16_bf16(pa0, PK(l0, h0), od, 0, 0, 0);
    od = __builtin_amdgcn_mfma_f32_32x32x16_bf16(pa1, PK(l1, h1), od, 0, 0, 0);
    od = __builtin_amdgcn_mfma_f32_32x32x16_bf16(pa2, PK(l2, h2), od, 0, 0, 0);
    od = __builtin_amdgcn_mfma_f32_32x32x16_bf16(pa3, PK(l3, h3), od, 0, 0, 0);
#undef PK
}
__device__ __forceinline__ void attn_unit(const bf16_t* __restrict__ Q, const bf16_t* __restrict__ K, const bf16_t* __restrict__ V, bf16_t* __restrict__ MIX, float* __restrict__ ssq_a,
                                          int row0, int h, int s0, int seq, LAS unsigned char* lds) {
    int tid = threadIdx.x; asm volatile("" : "+v"(tid));
    const int wid = tid >> 6, lane = tid & 63, r32 = lane & 31, hi = lane >> 5;
    LAS unsigned char* V_lds = lds + OFF_V; LAS unsigned char* K_lds = lds + OFF_K;
    LAS float* wsf = (LAS float*)(lds + OFF_WS) + wid * 64; LAS float* li_l = wsf; LAS float* al_l = wsf + 32;
    float m_reg = -1e30f, l_reg = 0; f32x16 o[2] = {}; bf16x8 qr[DQK / 16];
    const bf16_t* Qw = Q + (size_t)(row0 + wid * QBLK + r32) * 768 + h * DQK + hi * 8;
#pragma unroll
    for (int d0 = 0; d0 < DQK / 16; ++d0) qr[d0] = *(const bf16x8*)(Qw + d0 * 16);
    const bf16_t* Kh = K + (size_t)s0 * 768 + h * DQK; const bf16_t* Vh = V + (size_t)s0 * 512 + h * DV;
    const int kr0 = tid / 12, kc0 = tid % 12, kr1 = (512 + tid) / 12, kc1 = (512 + tid) % 12, vr = tid >> 3, vc = tid & 7;
    const bool k2 = tid < 256;
    const int kst0 = KSWZ(kr0, kc0 * 16), kst1 = KSWZ(kr1, kc1 * 16), vst = v_st(vr, vc * 8);
    const bf16_t* kg0 = Kh + (size_t)kr0 * 768 + kc0 * 8; const bf16_t* kg1 = Kh + (size_t)kr1 * 768 + kc1 * 8; const bf16_t* vg = Vh + (size_t)vr * 512 + vc * 8;
    const int vb0 = (int)(unsigned)(uintptr_t)V_lds + v_rd_base(lane);
    struct { bf16x8 k0, k1, v; } sr_[2];
#define SLOAD(i, kk0) do { sr_[i].k0 = *(const bf16x8*)(kg0 + (size_t)(kk0) * 768); if (k2) sr_[i].k1 = *(const bf16x8*)(kg1 + (size_t)(kk0) * 768); sr_[i].v = *(const bf16x8*)(vg + (size_t)(kk0) * 512); } while (0)
#define SWRITE(b, i) do { *(LAS bf16x8*)(V_lds + (b) * SHM_V + vst) = sr_[i].v; *(LAS bf16x8*)(K_lds + (b) * SHM_K + kst0) = sr_[i].k0; if (k2) *(LAS bf16x8*)(K_lds + (b) * SHM_K + kst1) = sr_[i].k1; } while (0)
#define RESC(a) do { if (__any((a) < 1.f)) { if (hi == 0) al_l[r32] = (a); asm volatile("s_waitcnt lgkmcnt(0)" ::: "memory"); \
    _Pragma("unroll") for (int d = 0; d < 2; ++d) _Pragma("unroll") for (int r = 0; r < 16; ++r) o[d][r] *= al_l[crow(r, hi)]; } } while (0)
    f32x16 pA0, pA1, pB0, pB1; float alA, alB; bf16x8 pa0, pa1, pa2, pa3; const int NT = seq / KVBLK;
    SLOAD(0, 0); SWRITE(0, 0); __syncthreads();
    qkt(pA0, pA1, K_lds, qr, r32, hi); partialSM(pA0, pA1, m_reg, alA);
    SLOAD(1, KVBLK); SLOAD(0, 2 * KVBLK);
    SWRITE(1, 1); __syncthreads();
    for (int j = 1; j + 1 < NT; j += 2) {
        SBAR(); qkt(pB0, pB1, K_lds + SHM_K, qr, r32, hi);
        finishSM(pA0, pA1, alA, l_reg, pa0, pa1, pa2, pa3); SBAR();
        SLOAD(1, (j + 2) * KVBLK); SBAR();
        pv_one<0>(o[0], vb0, pa0, pa1, pa2, pa3); pv_one<1>(o[1], vb0, pa0, pa1, pa2, pa3); partialSM(pB0, pB1, m_reg, alB);
        __syncthreads(); SWRITE(0, 0);
        RESC(alB); __syncthreads();
        SBAR(); qkt(pA0, pA1, K_lds, qr, r32, hi);
        finishSM(pB0, pB1, alB, l_reg, pa0, pa1, pa2, pa3); SBAR();
        if (j + 3 < NT) SLOAD(0, (j + 3) * KVBLK); SBAR();
        pv_one<0>(o[0], vb0 + SHM_V, pa0, pa1, pa2, pa3); pv_one<1>(o[1], vb0 + SHM_V, pa0, pa1, pa2, pa3); partialSM(pA0, pA1, m_reg, alA);
        __syncthreads(); SWRITE(1, 1);
        RESC(alA); __syncthreads();
    }
    SBAR(); qkt(pB0, pB1, K_lds + SHM_K, qr, r32, hi);
    finishSM(pA0, pA1, alA, l_reg, pa0, pa1, pa2, pa3); SBAR();
    pv_one<0>(o[0], vb0, pa0, pa1, pa2, pa3); pv_one<1>(o[1], vb0, pa0, pa1, pa2, pa3); partialSM(pB0, pB1, m_reg, alB);
    __syncthreads(); RESC(alB);
    finishSM(pB0, pB1, alB, l_reg, pa0, pa1, pa2, pa3); SBAR();
    pv_one<0>(o[0], vb0 + SHM_V, pa0, pa1, pa2, pa3); pv_one<1>(o[1], vb0 + SHM_V, pa0, pa1, pa2, pa3);
    if (hi == 0) li_l[r32] = l_reg; asm volatile("s_waitcnt lgkmcnt(0)" ::: "memory");
    bf16_t* Ow = MIX + (size_t)(row0 + wid * QBLK) * 1024 + h * DV;
#pragma unroll
    for (int r = 0; r < 16; ++r) { const int orow = crow(r, hi); const float rl = __builtin_amdgcn_rcpf(li_l[orow]);
        const float a = o[0][r] * rl, b = o[1][r] * rl;
        Ow[(size_t)orow * 1024 + r32] = (bf16_t)f2bf(a); Ow[(size_t)orow * 1024 + 32 + r32] = (bf16_t)f2bf(b);
        float ss = a * a + b * b;
        ss += __shfl_xor(ss, 1); ss += __shfl_xor(ss, 2); ss += __shfl_xor(ss, 4); ss += __shfl_xor(ss, 8); ss += __shfl_xor(ss, 16);
        if (r32 == 0) atomicAdd(ssq_a + row0 + wid * QBLK + orow, ss); }
    __syncthreads();
#undef SLOAD
#undef SWRITE
#undef RESC
}
__device__ __forceinline__ void attn_phase(const bf16_t* Q, const bf16_t* K, const bf16_t* V, bf16_t* MIX, float* ssq_a, int vcu, int G, LAS unsigned char* lds) {
    constexpr int NU = 512 + 1024;
    const int nmine = (G == 256) ? 6 : (NU - vcu + G - 1) / G;
#pragma unroll 1
    for (int i = 0; i < nmine; ++i) {
        int u;
        if (G == 256) { const int x = vcu >> 5, l = vcu & 31; u = (i < 2) ? x * 64 + l + 32 * i : 512 + (8 * x) * 16 + (i - 2) * 32 + l; }
        else u = vcu + i * G;
        int row0, h, s0, seq;
        if (u < 512) { row0 = M_PROMPT + (u & 63) * 256; h = u >> 6; s0 = M_PROMPT; seq = SEQ_S; }
        else { const int pu = u - 512, bh = pu >> 4, qb = pu & 15, b = bh >> 3; h = bh & 7; s0 = b * SEQ_P; row0 = s0 + qb * 256; seq = SEQ_P; }
        attn_unit(Q, K, V, MIX, ssq_a, row0, h, s0, seq, lds);
    }
}
#undef KSWZ
#undef SBAR
}

__device__ __forceinline__ void ssm_scan(const float* __restrict__ LST, bf16_t* __restrict__ UA, const float* __restrict__ AT, int vb, int tid) {
    const int r = vb * (NWAVES * 64) + tid;
    if (r >= 9 * 4096) return;
    const int sq = r >> 12, rem = r & 4095, dir = rem >> 11, g = (rem >> 6) & 31, n = rem & 63;
    const int s0 = sq < 8 ? sq * SEQ_P : M_PROMPT, len = sq < 8 ? SEQ_P : SEQ_S, nch = len / CT, c0 = s0 / CT;
    const float ar = AT[2 * ((dir * NG + g) * NS + n)], ai = AT[2 * ((dir * NG + g) * NS + n) + 1];
    const size_t off = (size_t)g * 256 + dir * 128 + n;
    const int step = dir == 0 ? 1 : -1; int c = dir == 0 ? c0 : c0 + nch - 1;
    float xr = 0.f, xi = 0.f;
    float lr[16], li[16];
#pragma unroll
    for (int k = 0; k < 16; ++k) { const float* lp = LST + (size_t)(c + k * step) * 8192 + off; lr[k] = lp[0]; li[k] = lp[64]; }
    for (int b = 0; b < nch; b += 16) {
        float nr[16], ni[16];
        const bool more = b + 16 < nch;
#pragma unroll
        for (int k = 0; k < 16; ++k) { const float* lp = LST + (size_t)(c + (more ? (16 + k) * step : 0)) * 8192 + off; nr[k] = lp[0]; ni[k] = lp[64]; }
#pragma unroll
        for (int k = 0; k < 16; ++k) {
            bf16_t* up = UA + (size_t)(c + k * step) * 16384 + g * 512 + 256 + dir * 128 + n;
            up[0] = (bf16_t)f2bf(xr); up[64] = (bf16_t)f2bf(xi);
            const float tr = ar * xr - ai * xi + lr[k], ti = ar * xi + ai * xr + li[k]; xr = tr; xi = ti;
        }
#pragma unroll
        for (int k = 0; k < 16; ++k) { lr[k] = nr[k]; li[k] = ni[k]; }
        c += 16 * step;
    }
}

#define XB_TMO      128
#define XB_XCNT(j)  (256  + 64 * (j))
#define XB_XSUB(j)  (1280 + 64 * (j))
#define XB_XGEN(j)  (2304 + 64 * (j))
#define XB_TOP      3328
#define XB_TOPGEN   3392
#define XCD_BAR_WORDS 3456
#define XB_SPIN_CAP (1u << 22)
__device__ __forceinline__ unsigned xb_ld(unsigned* p)              { return __hip_atomic_load(p, __ATOMIC_RELAXED, __HIP_MEMORY_SCOPE_AGENT); }
__device__ __forceinline__ unsigned xb_add(unsigned* p, unsigned v) { return __hip_atomic_fetch_add(p, v, __ATOMIC_RELAXED, __HIP_MEMORY_SCOPE_AGENT); }
__device__ __forceinline__ unsigned xb_xcc_id() { return (unsigned)__builtin_amdgcn_s_getreg((3 << 11) | 20) & 0xFu; }
#define XB_SPIN(cond, bar) do { unsigned _sp = 0; while (cond) { __builtin_amdgcn_s_sleep(1); \
    if ((++_sp & 255u) == 0u) { if (xb_ld(&(bar)[XB_TMO])) break; if (_sp > XB_SPIN_CAP) { atomicAdd(&(bar)[XB_TMO], 1u); break; } } } } while (0)
struct XcdBarrier { unsigned* bar; unsigned x; volatile LAS unsigned* st; };
__device__ __forceinline__ XcdBarrier xcd_barrier_post(unsigned* bar, volatile LAS unsigned* st) {
    XcdBarrier b; b.bar = bar; b.x = xb_xcc_id(); b.st = st;
    if (threadIdx.x == 0) (void)xb_add(&bar[XB_XCNT(b.x)], 1u);
    return b;
}
__device__ __forceinline__ void xcd_barrier_complete(unsigned* bar, unsigned x, unsigned& nloc, unsigned& nx) {
    const unsigned G = gridDim.x * gridDim.y * gridDim.z;
    unsigned sum, cnt, mine, sp = 0u;
    for (;;) {
        sum = 0u; cnt = 0u; mine = 0u;
#pragma unroll
        for (unsigned j = 0; j < 16; ++j) { const unsigned c = xb_ld(&bar[XB_XCNT(j)]); sum += c; cnt += (c > 0u) ? 1u : 0u; mine = (j == x) ? c : mine; }
        if (sum == G) break;
        __builtin_amdgcn_s_sleep(1);
        if ((++sp & 255u) == 0u) { if (xb_ld(&bar[XB_TMO])) break; if (sp > XB_SPIN_CAP) { atomicAdd(&bar[XB_TMO], 1u); break; } }
    }
    nloc = mine > 0u ? mine : 1u; nx = cnt > 0u ? cnt : 1u;
}
__device__ __forceinline__ void xcd_barrier(const XcdBarrier& b) {
    asm volatile("s_waitcnt vmcnt(0)" ::: "memory");
    __syncthreads();
    if (threadIdx.x == 0) {
        unsigned* bar = b.bar;
        __builtin_amdgcn_s_waitcnt(0);
        unsigned nloc = b.st[0], nx = b.st[1];
        if (nloc == 0u) { xcd_barrier_complete(bar, b.x, nloc, nx); b.st[0] = nloc; b.st[1] = nx; }
        const unsigned old = xb_add(&bar[XB_XSUB(b.x)], 1u);
        const unsigned gen = old / nloc;
        if (old + 1u == (gen + 1u) * nloc) {
            __builtin_amdgcn_fence(__ATOMIC_RELEASE, "agent");
            asm volatile("s_waitcnt vmcnt(0)" ::: "memory");
            const unsigned og = xb_add(&bar[XB_TOP], 1u);
            const unsigned tg = og / nx;
            if (og + 1u == (tg + 1u) * nx) xb_add(&bar[XB_TOPGEN], 1u);
            else XB_SPIN(xb_ld(&bar[XB_TOPGEN]) == tg, bar);
            __builtin_amdgcn_fence(__ATOMIC_ACQUIRE, "agent");
            xb_add(&bar[XB_XGEN(b.x)], 1u);
            asm volatile("s_waitcnt vmcnt(0)" ::: "memory");
        } else {
            XB_SPIN(xb_ld(&bar[XB_XGEN(b.x)]) == gen, bar);
            __builtin_amdgcn_fence(__ATOMIC_ACQUIRE, "agent");
            asm volatile("s_waitcnt vmcnt(0)" ::: "memory");
        }
    }
    __syncthreads();
}

constexpr int LDS_BYTES = 147456, MISC_OFF = 131072 + 320;
constexpr int N_PHASES = 14;
constexpr int CW_BAR = 4096;
__global__ void __launch_bounds__(NWAVES * 64, 2) mega(Params p) {
    extern __shared__ __attribute__((aligned(16))) unsigned char lds_raw[];
    LAS unsigned char* lds = (LAS unsigned char*)lds_raw;
    const int G = gridDim.x, bx = blockIdx.x, tid = threadIdx.x;
    const int vcu = (G % 8 == 0) ? (bx % 8) * (G / 8) + bx / 8 : bx;
    unsigned char* ws = p.ws;
    volatile LAS unsigned* MISC = (volatile LAS unsigned*)(lds + MISC_OFF);
    for (int u = tid; u < (LDS_BYTES - 131072) / 4; u += NWAVES * 64) ((LAS unsigned*)(lds + 131072))[u] = 0u;
    __syncthreads();
    const int lo = p.ph_lo, hi = p.ph_hi;
    XcdBarrier bar; bar.bar = (unsigned*)(ws + WS_CTL) + CW_BAR; bar.x = 0; bar.st = nullptr;
    if (hi - lo > 1) bar = xcd_barrier_post((unsigned*)(ws + WS_CTL) + CW_BAR, MISC + 8);
#ifndef PH_MASK
#define PH_MASK 0xFFFFu
#endif
#define IN(k) (((PH_MASK >> (k)) & 1u) && lo <= (k) && (k) < hi)
#define SEAM(k) do { if (IN(k) && IN((k) + 1)) xcd_barrier(bar); } while (0)
    float* stat = (float*)(ws + WS_STAT);
    const float* cosT = (const float*)(ws + WS_ROPE); const float* sinT = cosT + SEQ_S * 16;
    bf16_t* PROJ = (bf16_t*)(ws + WS_PROJ); bf16_t* GB = (bf16_t*)(ws + WS_PROJ); bf16_t* UA = (bf16_t*)(ws + WS_UA); bf16_t* X1B = (bf16_t*)(ws + WS_UA);
    bf16_t* XB = (bf16_t*)(ws + WS_XB); float* LST = (float*)(ws + WS_XB); bf16_t* HB = (bf16_t*)(ws + WS_XB); bf16_t* MIX = (bf16_t*)(ws + WS_MIX);
    bf16_t* Qb = (bf16_t*)p.out; bf16_t* Kb = Qb + (size_t)M_TOK * 768; bf16_t* Vb = Kb + (size_t)M_TOK * 768;

    if (IN(0)) { prologue(p, lds, vcu, G); } SEAM(0);
    if (IN(1)) { EpiProj e{stat + ST_RSTD1 * M_TOK, PROJ, UA, cosT, sinT, stat + ST_SSQ * M_TOK, stat + ST_SSKV * M_TOK};
        pg8::run_gemm(lds, XB, 1024, 0, (const bf16_t*)(ws + WS_WIN), 1024, M_TOK, 1024, 1024, e, G, bx); } SEAM(1);
    if (IN(2)) {
#ifndef P2SEL
#define P2SEL 7
#endif
        if (P2SEL & 1) { EpiQ e{stat + ST_SSQ * M_TOK, Qb, cosT, sinT}; pg8::run_gemm(lds, PROJ, 512, 0, (const bf16_t*)(ws + WS_WUQ), 256, M_TOK, 768, 256, e, G, bx); }
        if (P2SEL & 2) { EpiKV e{stat + ST_SSKV * M_TOK, PROJ, Kb, Vb}; pg8::run_gemm(lds, PROJ + 256, 512, 0, (const bf16_t*)(ws + WS_WUKV), 128, M_TOK, 1024, 128, e, G, bx); }
        if (P2SEL & 4) { EpiLst e{LST}; pg8::run_gemm(lds, UA, 16384, 512, (const bf16_t*)(ws + WS_SP), 256, NCHUNK, 8192, 256, e, G, bx); }
    } SEAM(2);
    if (IN(3)) { ssm_scan(LST, UA, (const float*)(ws + WS_AT), vcu, tid); att::attn_phase(Qb, Kb, Vb, MIX, stat + ST_SSA * M_TOK, vcu, G, lds); } SEAM(3);
    if (IN(4)) { EpiSsmOut e{GB}; pg8::run_gemm(lds, UA, 16384, 512, (const bf16_t*)(ws + WS_MQ), 512, NCHUNK, 8192, 512, e, G, bx); } SEAM(4);
    if (IN(5)) { EpiGlu e{GB, p.in[17], MIX, stat + ST_SSS * M_TOK}; pg8::run_gemm(lds, GB, 512, 0, (const bf16_t*)(ws + WS_WGLU), 512, M_TOK, 512, 512, e, G, bx); } SEAM(5);
    if (IN(6)) { EpiOut e{p.in[0], p.in[1], stat + ST_SSS * M_TOK, p.out, X1B, stat + ST_SSX1 * M_TOK};
        pg8::run_gemm(lds, MIX, 1024, 0, (const bf16_t*)(ws + WS_WOUT), 1024, M_TOK, 1024, 1024, e, G, bx, 8, stat + ST_SSA * M_TOK, stat + ST_SSS * M_TOK); } SEAM(6);
#pragma unroll 1
    for (int th = 0; th < 3; ++th) {
        const int r0 = th * 16384;
        if (IN(7 + 2 * th)) { EpiMlp1 e{stat + ST_SSX1 * M_TOK, HB, r0, 0};
            pg8::run_gemm(lds, X1B + (size_t)r0 * DM, 1024, 0, (const bf16_t*)(ws + WS_W1), 1024, 16384, 4096, 1024, e, G, bx); } SEAM(7 + 2 * th);
        if (IN(8 + 2 * th)) { EpiMlp2 e{p.out + (size_t)r0 * DM, stat + ST_SSX2 * M_TOK + r0, r0, 0};
            pg8::run_gemm(lds, HB, 4096, 0, (const bf16_t*)(ws + WS_W2), 4096, 16384, 1024, 4096, e, G, bx); } SEAM(8 + 2 * th);
    }
    if (IN(13)) final_norm_rows(p.out, stat + ST_SSX2 * M_TOK, p.in[24], vcu * NWAVES + (tid >> 6), G * NWAVES, tid & 63);
#undef IN
#undef SEAM
}

extern "C" void kernel_launch(void* const* d_in, const int* in_sizes, int n_in, void* d_out, int out_size, void* d_ws, size_t ws_size, hipStream_t stream) {
    static int ok = 0;
    if (ok == 0) {
        if (n_in != 25 || out_size != M_TOK * DM || ws_size < WS_END) { fprintf(stderr, "kernel_launch: unexpected shapes n_in %d out %d ws %zu\n", n_in, out_size, ws_size); ok = -1; return; }
        if (hipFuncSetAttribute((const void*)mega, hipFuncAttributeMaxDynamicSharedMemorySize, LDS_BYTES) != hipSuccess) { fprintf(stderr, "kernel_launch: LDS attribute failed\n"); ok = -1; return; }
        ok = 1;
    }
    if (ok < 0) return;
    Params p{};
    for (int i = 0; i < 25; ++i) p.in[i] = (const float*)d_in[i];
    p.out = (float*)d_out; p.ws = (unsigned char*)d_ws;
    unsigned char* ws = (unsigned char*)d_ws;
    float* stat = (float*)(ws + WS_STAT);
    const float* cosT = (const float*)(ws + WS_ROPE); const float* sinT = cosT + SEQ_S * 16;
    bf16_t* PROJ = (bf16_t*)(ws + WS_PROJ); bf16_t* GB = (bf16_t*)(ws + WS_PROJ); bf16_t* UA = (bf16_t*)(ws + WS_UA); bf16_t* X1B = (bf16_t*)(ws + WS_UA);
    bf16_t* XB = (bf16_t*)(ws + WS_XB); float* YB = (float*)(ws + WS_XB); bf16_t* HB = (bf16_t*)(ws + WS_XB); bf16_t* MIX = (bf16_t*)(ws + WS_MIX);
    bf16_t* Qb = (bf16_t*)d_out; bf16_t* Kb = Qb + (size_t)M_TOK * 768; bf16_t* Vb = Kb + (size_t)M_TOK * 768;
    (void)hipMemsetAsync(ws + WS_CTL, 0, 1 * MiB, stream);
#define MEGA(a, b) do { p.ph_lo = (a); p.ph_hi = (b); hipLaunchKernelGGL(mega, dim3(256), dim3(512), LDS_BYTES, stream, p); } while (0)
    MEGA(0, N_PHASES);
#undef MEGA
}
```

```cpp
#include <hip/hip_runtime.h>
#include <cstdint>
#include <cstdio>

typedef unsigned short bf16_t;
typedef short bf16x8 __attribute__((ext_vector_type(8)));
typedef float f32x4 __attribute__((ext_vector_type(4)));
typedef float f32x2 __attribute__((ext_vector_type(2)));
typedef unsigned u32x4 __attribute__((ext_vector_type(4)));
typedef unsigned u32x2 __attribute__((ext_vector_type(2)));
#define LAS __attribute__((address_space(3)))

constexpr int DM = 1024, M_TOK = 49152, M_PROMPT = 32768, SEQ_P = 4096, SEQ_S = 16384;
constexpr int NH = 8, DQK = 96, DNOPE = 64, DROPE = 32, DV = 64, QR = 256, KVR = 128;
constexpr int SSMW = 512, NG = 32, GH = 16, NS = 64, DFF = 4096, INW = 928;
constexpr int CT = 16, NCHUNK = M_TOK / CT;
constexpr float EPS = 1e-6f;
constexpr float QSCALE = 0.10206207261596575f * 1.4426950408889634f;

constexpr size_t MiB = 1u << 20;
constexpr size_t WS_CTL = 0;
constexpr size_t WS_WIN = 1 * MiB;
constexpr size_t WS_WUQ = 3 * MiB;
constexpr size_t WS_WUKV = 3 * MiB + 384 * 1024;
constexpr size_t WS_WGLU = 4 * MiB;
constexpr size_t WS_WOUT = 5 * MiB;
constexpr size_t WS_W1 = 7 * MiB;
constexpr size_t WS_W2 = 15 * MiB;
constexpr size_t WS_MQ = 23 * MiB;
constexpr size_t WS_SP = 31 * MiB;
constexpr size_t WS_ROPE = 35 * MiB;
constexpr size_t WS_STAT = 37 * MiB;
constexpr size_t WS_AT = 39 * MiB;
constexpr size_t WS_ESEG = 39 * MiB + 64 * 1024;
constexpr size_t WS_PROJ = 40 * MiB;
constexpr size_t WS_UA = 88 * MiB;
constexpr size_t WS_XB = 184 * MiB;
constexpr size_t WS_MIX = 312 * MiB;
constexpr size_t WS_END = 408 * MiB;
enum { ST_RSTD1 = 0, ST_SSQ = 1, ST_SSKV = 2, ST_SSA = 3, ST_SSS = 4, ST_SSX1 = 5, ST_SSX2 = 6 };

struct Params {
    const float* in[25];
    float* out;
    unsigned char* ws;
    int ph_lo, ph_hi;
};

__device__ __forceinline__ unsigned f2bf(float f) { unsigned u = __builtin_bit_cast(unsigned, f); return (u + 0x7fffu + ((u >> 16) & 1u)) >> 16; }
__device__ __forceinline__ unsigned pk2(float lo, float hi) { return f2bf(lo) | (f2bf(hi) << 16); }
__device__ __forceinline__ float bf2f(unsigned short b) { return __builtin_bit_cast(float, (unsigned)b << 16); }
__device__ __forceinline__ void store8bf(bf16_t* p, f32x4 a, f32x4 b) {
    u32x4 w; w.x = pk2(a[0], a[1]); w.y = pk2(a[2], a[3]); w.z = pk2(b[0], b[1]); w.w = pk2(b[2], b[3]); *(u32x4*)p = w;
}
__device__ __forceinline__ void load8bf(const bf16_t* p, f32x4& a, f32x4& b) {
    const u32x4 w = *(const u32x4*)p;
    a[0] = __builtin_bit_cast(float, w.x << 16); a[1] = __builtin_bit_cast(float, w.x & 0xffff0000u);
    a[2] = __builtin_bit_cast(float, w.y << 16); a[3] = __builtin_bit_cast(float, w.y & 0xffff0000u);
    b[0] = __builtin_bit_cast(float, w.z << 16); b[1] = __builtin_bit_cast(float, w.z & 0xffff0000u);
    b[2] = __builtin_bit_cast(float, w.w << 16); b[3] = __builtin_bit_cast(float, w.w & 0xffff0000u);
}
__device__ __forceinline__ float sumsq8(f32x4 a, f32x4 b) { return (a[0] * a[0] + a[1] * a[1]) + (a[2] * a[2] + a[3] * a[3]) + (b[0] * b[0] + b[1] * b[1]) + (b[2] * b[2] + b[3] * b[3]); }
__device__ __forceinline__ int rope_logical(int p) { const int i = p & 7, gq = p >> 3; return i < 4 ? 4 * gq + i : 16 + 4 * gq + (i - 4); }
__device__ __forceinline__ int tok_pos(int row) { return row < M_PROMPT ? (row & (SEQ_P - 1)) : row - M_PROMPT; }
__device__ __forceinline__ int perm32(int rho) { const int n = rho >> 4, i = rho & 15; return 8 * (i >> 2) + 4 * n + (i & 3); }
__device__ __forceinline__ float wave_sum(float v) {
#pragma unroll
    for (int o = 1; o < 64; o <<= 1) v += __shfl_xor(v, o);
    return v;
}
__device__ __forceinline__ float gelu_tanh(float x) {
    const float z = 0.7978845608028654f * (x + 0.044715f * x * x * x);
    const float e = __expf(2.f * z);
    const float th = 1.f - 2.f / (1.f + e);
    return 0.5f * x * (1.f + th);
}

struct EpiProj {
    const float* rstd1; bf16_t* proj; bf16_t* ua; const float* cosT; const float* sinT; float* ssq_q; float* ssq_kv;
    __device__ __forceinline__ float* ssq(int pn) const { return pn == 0 ? ssq_q : (pn == 1 ? ssq_kv : nullptr); }
    __device__ __forceinline__ float operator()(int row, int col, f32x4 v0, f32x4 v1) const {
        const float r = rstd1[row]; v0 = v0 * r; v1 = v1 * r;
        if (col < 384) { store8bf(proj + (size_t)row * 512 + col, v0, v1); return sumsq8(v0, v1); }
        if (col < 416) {
            const int pos = tok_pos(row), gq = (col - 384) >> 3;
            const f32x4 c = *(const f32x4*)(cosT + pos * 16 + gq * 4), s = *(const f32x4*)(sinT + pos * 16 + gq * 4);
            const f32x4 o1 = v0 * c - v1 * s, o2 = v1 * c + v0 * s;
            store8bf(proj + (size_t)row * 512 + col, o1, o2); return 0.f;
        }
        if (col < 512) return 0.f;
        const int c2 = col - 512, g = c2 >> 4, h0 = c2 & 15, chunk = row >> 4, t = row & 15;
        store8bf(ua + ((size_t)chunk * 32 + g) * 512 + t * 16 + h0, v0, v1); return 0.f;
    }
};
struct EpiQ {
    const float* ssq_q; bf16_t* q; const float* cosT; const float* sinT;
    __device__ __forceinline__ float* ssq(int) const { return nullptr; }
    __device__ __forceinline__ float operator()(int row, int col, f32x4 v0, f32x4 v1) const {
        const float r = rsqrtf(ssq_q[row] * (1.f / QR) + EPS); v0 = v0 * r; v1 = v1 * r;
        const int d = col % DQK;
        if (d >= DNOPE) {
            const int pos = tok_pos(row), gq = (d - DNOPE) >> 3;
            const f32x4 c = *(const f32x4*)(cosT + pos * 16 + gq * 4), s = *(const f32x4*)(sinT + pos * 16 + gq * 4);
            const f32x4 o1 = v0 * c - v1 * s, o2 = v1 * c + v0 * s; v0 = o1; v1 = o2;
        }
        store8bf(q + (size_t)row * 768 + col, v0 * QSCALE, v1 * QSCALE); return 0.f;
    }
};
struct EpiKV {
    const float* ssq_kv; const bf16_t* proj; bf16_t* k; bf16_t* v;
    __device__ __forceinline__ float* ssq(int) const { return nullptr; }
    __device__ __forceinline__ float operator()(int row, int col, f32x4 v0, f32x4 v1) const {
        const float r = rsqrtf(ssq_kv[row] * (1.f / KVR) + EPS); v0 = v0 * r; v1 = v1 * r;
        const int h = col >> 7, w = col & 127;
        if (w < 64) {
            store8bf(k + (size_t)row * 768 + h * DQK + w, v0, v1);
            if (w < 32) *(u32x4*)(k + (size_t)row * 768 + h * DQK + 64 + w) = *(const u32x4*)(proj + (size_t)row * 512 + 384 + w);
        } else store8bf(v + (size_t)row * 512 + h * DV + (w - 64), v0, v1);
        return 0.f;
    }
};
struct EpiLst {
    float* lst;
    __device__ __forceinline__ float* ssq(int) const { return nullptr; }
    __device__ __forceinline__ float operator()(int row, int col, f32x4 v0, f32x4 v1) const {
        float* o = lst + (size_t)row * 8192 + col; *(f32x4*)o = v0; *(f32x4*)(o + 4) = v1; return 0.f;
    }
};
struct EpiSsmOut {
    bf16_t* g;
    __device__ __forceinline__ float* ssq(int) const { return nullptr; }
    __device__ __forceinline__ float operator()(int row, int col, f32x4 v0, f32x4 v1) const {
        const int grp = col >> 8, t = (col >> 4) & 15, h0 = col & 15;
#pragma unroll
        for (int i = 0; i < 4; ++i) { v0[i] = gelu_tanh(v0[i]); v1[i] = gelu_tanh(v1[i]); }
        store8bf(g + ((size_t)row * 16 + t) * 512 + grp * 16 + h0, v0, v1); return 0.f;
    }
};
struct EpiGlu {
    const bf16_t* g; const float* bias; bf16_t* mix; float* ssq_s;
    __device__ __forceinline__ float* ssq(int) const { return ssq_s; }
    __device__ __forceinline__ float operator()(int row, int col, f32x4 v0, f32x4 v1) const {
        f32x4 g0, g1; load8bf(g + (size_t)row * 512 + col, g0, g1);
        const f32x4 b0 = *(const f32x4*)(bias + col), b1 = *(const f32x4*)(bias + col + 4);
#pragma unroll
        for (int i = 0; i < 4; ++i) { v0[i] = g0[i] / (1.f + __expf(-(v0[i] + b0[i]))); v1[i] = g1[i] / (1.f + __expf(-(v1[i] + b1[i]))); }
        store8bf(mix + (size_t)row * 1024 + 512 + col, v0, v1); return sumsq8(v0, v1);
    }
};
struct EpiOut {
    const float* xp; const float* xs; const float* ssq_s; float* x1; bf16_t* x1b; float* ssq_x1;
    __device__ __forceinline__ float* ssq(int) const { return ssq_x1; }
    __device__ __forceinline__ float operator()(int row, int col, f32x4 v0, f32x4 v1) const {
        const float r = rsqrtf(ssq_s[row] * (1.f / 512) + EPS);
        const float* xr = (row < M_PROMPT ? xp + (size_t)row * DM : xs + (size_t)(row - M_PROMPT) * DM) + col;
        v0 = *(const f32x4*)xr + v0 * r; v1 = *(const f32x4*)(xr + 4) + v1 * r;
        float* o = x1 + (size_t)row * DM + col; *(f32x4*)o = v0; *(f32x4*)(o + 4) = v1;
        store8bf(x1b + (size_t)row * DM + col, v0, v1); return sumsq8(v0, v1);
    }
};
struct EpiMlp1 {
    const float* ssq_x1; bf16_t* hb; int r0, pad;
    __device__ __forceinline__ float* ssq(int) const { return nullptr; }
    __device__ __forceinline__ float operator()(int row, int col, f32x4 v0, f32x4 v1) const {
        const float r = rsqrtf(ssq_x1[r0 + row] * (1.f / DM) + EPS);
#pragma unroll
        for (int i = 0; i < 4; ++i) { float a = fmaxf(v0[i] * r, 0.f), b = fmaxf(v1[i] * r, 0.f); v0[i] = a * a; v1[i] = b * b; }
        store8bf(hb + (size_t)row * DFF + col, v0, v1); return 0.f;
    }
};
struct EpiMlp2 {
    const float* xin; float* xout; float* ssq_x2; int r0, pad;
    __device__ __forceinline__ float* ssq(int) const { return ssq_x2; }
    __device__ __forceinline__ float operator()(int row, int col, f32x4 v0, f32x4 v1) const {
        const float* i = xin + (size_t)row * DM + col; float* o = xout + (size_t)row * DM + col;
        v0 = *(const f32x4*)i + v0; v1 = *(const f32x4*)(i + 4) + v1;
        *(f32x4*)o = v0; *(f32x4*)(o + 4) = v1; return sumsq8(v0, v1);
    }
};


namespace pg8 {
constexpr int BM = 256, BK = 64, HALF = 128, HTB = HALF * BK * 2, STAGE_BYTES = 8 * HTB, NXCD = 8, WGM = 8;
__host__ __device__ __forceinline__ int lds_byte(int r, int c) { const int st = (r >> 4) * 2 + (c >> 5), rr = r & 15, cc = c & 31, ob = rr * 64 + cc * 2; return st * 1024 + (ob ^ (((ob >> 9) & 1) << 5)); }
__host__ __device__ __forceinline__ void stage_rc(int b, int& R, int& C) { const int st = b / 1024, sb = b % 1024, swz = sb ^ (((sb >> 9) & 1) << 5); R = (st >> 1) * 16 + swz / 64; C = (st & 1) * 32 + (swz % 64) / 2; }
struct Unit { int pm, pn; };
struct Gemm { const bf16_t* A; const bf16_t* Bt; int M, N, K, lda, ldb, a_pn_off, resc_t; const float* ssa; const float* sss; };
struct StaticOrder {
    int nM, nN, nwg, G, c;
    __device__ void init(int M, int N, int G_, int c_) { nM = M / BM; nN = N / BM; nwg = nM * nN; G = G_; c = c_; }
    __device__ bool next(int i, Unit& u) const {
        const long L = (long)i * G + c; if (L >= nwg) return false;
        int wgid = (int)L; { const int q = nwg / NXCD, r = nwg % NXCD, xcd = wgid % NXCD, off = wgid / NXCD; wgid = (xcd < r ? xcd * (q + 1) : r * (q + 1) + (xcd - r) * q) + off; }
        const int nig = WGM * nN, gid = wgid / nig, fm = gid * WGM, gsz = (nM - fm) < WGM ? (nM - fm) : WGM;
        u.pm = fm + ((wgid % nig) % gsz); u.pn = (wgid % nig) / gsz; return true;
    }
};
template <class E> struct EpiW {
    E e;
    __device__ __forceinline__ void operator()(const f32x4 (&acc)[2][2][4][2], const Unit& u, int wr, int wc, int fr, int fq) const {
        float* tgt = e.ssq(u.pn);
#pragma unroll
        for (int ai = 0; ai < 2; ++ai)
#pragma unroll
            for (int m = 0; m < 4; ++m) {
                int row = u.pm * BM + ai * HALF + wr * 64 + m * 16 + fr; asm volatile("" : "+v"(row)); float s = 0.f;
#pragma unroll
                for (int bj = 0; bj < 2; ++bj) s += e(row, u.pn * BM + bj * HALF + wc * 32 + 8 * fq, acc[ai][bj][m][0], acc[ai][bj][m][1]);
                if (tgt) { s += __shfl_xor(s, 16); s += __shfl_xor(s, 32); if (fq == 0) atomicAdd(tgt + row, s); }
                asm volatile("" ::: "memory");
            }
    }
};
template <class Epi>
__device__ __forceinline__ void gemm_phase(LAS unsigned char* lds, const Gemm g, const StaticOrder& S, const Epi& E) {
    int tid = threadIdx.x; asm volatile("" : "+v"(tid));
    const int wid = __builtin_amdgcn_readfirstlane(tid >> 6), lane = tid & 63, wr = wid >> 2, wc = wid & 3, fr = lane & 15, fq = lane >> 4;
    const int K = g.K, nt = K / BK;
    unsigned voffA[2], voffB[2];
#pragma unroll
    for (int i = 0; i < 2; ++i) { int R, C; stage_rc(tid * 16 + i * 8192, R, C); const int Rb = (R & ~31) + perm32(R & 31);
        voffA[i] = (unsigned)(R * g.lda + C) * 2u; voffB[i] = (unsigned)(Rb * g.ldb + C) * 2u; }
    const size_t kstep = (size_t)(BK * 2);
    const size_t hstepA = (size_t)HALF * g.lda * 2, hstepB = (size_t)HALF * g.ldb * 2;
    const size_t tstepA = 2 * hstepA, tstepB = 2 * hstepB, pstepA = (size_t)g.a_pn_off * 2;
    const unsigned ldsw = (unsigned)wid * 1024u;
    const int aoff = lds_byte(wr * 64 + fr, fq * 8), boff = lds_byte(wc * 32 + fr, fq * 8);
#define PG8_SA(b, h) (((b) * 2 + (h)) * HTB)
#define PG8_SB(b, h) ((4 + (b) * 2 + (h)) * HTB)
#define PG8_STAGE(bufoff, gbase, voff) do { _Pragma("unroll") for (int _i = 0; _i < 2; ++_i) \
        __builtin_amdgcn_global_load_lds((const unsigned*)((const char*)(gbase) + (voff)[_i]), (LAS unsigned*)(lds + (bufoff) + ldsw + _i * 8192), 16, 0, 0); } while (0)
#define PG8_LDA(dst, b, h) do { _Pragma("unroll") for (int m = 0; m < 4; ++m) _Pragma("unroll") for (int k = 0; k < 2; ++k) dst[m][k] = *(const LAS bf16x8*)(lds + PG8_SA(b, h) + aoff + m * 2048 + k * 1024); } while (0)
#define PG8_LDB(dst, b, h) do { _Pragma("unroll") for (int n = 0; n < 2; ++n) _Pragma("unroll") for (int k = 0; k < 2; ++k) dst[n][k] = *(const LAS bf16x8*)(lds + PG8_SB(b, h) + boff + n * 2048 + k * 1024); } while (0)
#define PG8_MMA(ai, bj, At, Bt) do { __builtin_amdgcn_s_setprio(1); _Pragma("unroll") for (int m = 0; m < 4; ++m) _Pragma("unroll") for (int n = 0; n < 2; ++n) _Pragma("unroll") for (int k = 0; k < 2; ++k) \
        acc[ai][bj][m][n] = __builtin_amdgcn_mfma_f32_16x16x32_bf16(Bt[n][k], At[m][k], acc[ai][bj][m][n], 0, 0, 0); __builtin_amdgcn_s_setprio(0); } while (0)
#define PG8_WAIT_V(n) asm volatile("s_waitcnt vmcnt(" #n ")" ::: "memory")
#define PG8_WAIT_L(n) asm volatile("s_waitcnt lgkmcnt(" #n ")" ::: "memory")
#define PG8_BAR __builtin_amdgcn_s_barrier()
#define PG8_SCHED __builtin_amdgcn_sched_barrier(0)
    Unit cur, nxt; int ui = 0;
    if (!S.next(0, cur)) return;
    f32x4 acc[2][2][4][2];
#pragma unroll
    for (int a = 0; a < 2; ++a)
#pragma unroll
        for (int b = 0; b < 2; ++b)
#pragma unroll
            for (int m = 0; m < 4; ++m)
#pragma unroll
                for (int n = 0; n < 2; ++n) acc[a][b][m][n] = (f32x4){0.f, 0.f, 0.f, 0.f};
    bf16x8 At[4][2], B0[2][2], B1[2][2];
    const char* cA = (const char*)g.A + (size_t)cur.pm * tstepA + (size_t)cur.pn * pstepA; const char* cB = (const char*)g.Bt + (size_t)cur.pn * tstepB;
    PG8_STAGE(PG8_SB(0, 0), cB, voffB); PG8_STAGE(PG8_SB(0, 1), cB + hstepB, voffB); PG8_STAGE(PG8_SA(0, 0), cA, voffA); PG8_STAGE(PG8_SA(0, 1), cA + hstepA, voffA);
    if (wr == 1) PG8_BAR;
    PG8_WAIT_V(2); PG8_BAR;
    PG8_STAGE(PG8_SB(1, 0), cB + kstep, voffB); PG8_STAGE(PG8_SA(1, 0), cA + kstep, voffA); PG8_STAGE(PG8_SB(1, 1), cB + hstepB + kstep, voffB);
    PG8_WAIT_V(6); PG8_BAR;
    for (;;) {
        const bool has_next = S.next(ui + 1, nxt);
        const char* nA = has_next ? (const char*)g.A + (size_t)nxt.pm * tstepA + (size_t)nxt.pn * pstepA : cA; const char* nB = has_next ? (const char*)g.Bt + (size_t)nxt.pn * tstepB : cB;
        for (int t = 0; t < nt; t += 2) {
            const bool last = (t == nt - 2);
            const char* a1 = cA + (size_t)(t + 1) * kstep;
            const char* a2 = last ? nA : cA + (size_t)(t + 2) * kstep; const char* b2 = last ? nB : cB + (size_t)(t + 2) * kstep;
            const char* a3 = a2 + kstep; const char* b3 = b2 + kstep;
            if (t == g.resc_t) {
#pragma unroll
                for (int ai = 0; ai < 2; ++ai)
#pragma unroll
                    for (int m = 0; m < 4; ++m) { int row = cur.pm * BM + ai * HALF + wr * 64 + m * 16 + fr; asm volatile("" : "+v"(row));
                        const float f = sqrtf((g.sss[row] * (1.f / 512) + EPS) / (g.ssa[row] * (1.f / 512) + EPS));
#pragma unroll
                        for (int bj = 0; bj < 2; ++bj) { acc[ai][bj][m][0] = acc[ai][bj][m][0] * f; acc[ai][bj][m][1] = acc[ai][bj][m][1] * f; }
                        asm volatile("" ::: "memory"); }
            }
            PG8_LDB(B0, 0, 0); PG8_LDB(B1, 0, 1); PG8_SCHED; PG8_LDA(At, 0, 0); PG8_STAGE(PG8_SA(1, 1), a1 + hstepA, voffA);
            PG8_WAIT_V(8); PG8_WAIT_L(0); PG8_BAR; PG8_MMA(0, 0, At, B0); PG8_MMA(0, 1, At, B1); PG8_BAR; PG8_SCHED;
            PG8_LDA(At, 0, 1); PG8_STAGE(PG8_SB(0, 0), b2, voffB); PG8_STAGE(PG8_SB(0, 1), b2 + hstepB, voffB); PG8_STAGE(PG8_SA(0, 0), a2, voffA);
            PG8_WAIT_V(8); PG8_WAIT_L(0); PG8_BAR; PG8_MMA(1, 0, At, B0); PG8_MMA(1, 1, At, B1); PG8_BAR; PG8_SCHED;
            PG8_LDB(B0, 1, 0); PG8_LDB(B1, 1, 1); PG8_SCHED; PG8_LDA(At, 1, 0); PG8_STAGE(PG8_SA(0, 1), a2 + hstepA, voffA);
            PG8_WAIT_V(8); PG8_WAIT_L(0); PG8_BAR; PG8_MMA(0, 0, At, B0); PG8_MMA(0, 1, At, B1); PG8_BAR; PG8_SCHED;
            PG8_LDA(At, 1, 1); PG8_STAGE(PG8_SB(1, 0), b3, voffB); PG8_STAGE(PG8_SB(1, 1), b3 + hstepB, voffB); PG8_STAGE(PG8_SA(1, 0), a3, voffA);
            PG8_WAIT_V(8); PG8_WAIT_L(0); PG8_BAR; PG8_MMA(1, 0, At, B0); PG8_MMA(1, 1, At, B1); PG8_BAR; PG8_SCHED;
        }
        if (wr == 0) PG8_BAR;
        E(acc, cur, wr, wc, fr, fq);
        if (!has_next) break;
#pragma unroll
        for (int a = 0; a < 2; ++a)
#pragma unroll
            for (int b = 0; b < 2; ++b)
#pragma unroll
                for (int m = 0; m < 4; ++m)
#pragma unroll
                    for (int n = 0; n < 2; ++n) acc[a][b][m][n] = (f32x4){0.f, 0.f, 0.f, 0.f};
        cur = nxt; cA = nA; cB = nB; ++ui;
        if (wr == 1) PG8_BAR;
    }
    PG8_WAIT_V(0);
    PG8_BAR;
#undef PG8_SA
#undef PG8_SB
#undef PG8_STAGE
#undef PG8_LDA
#undef PG8_LDB
#undef PG8_MMA
#undef PG8_WAIT_V
#undef PG8_WAIT_L
#undef PG8_BAR
#undef PG8_SCHED
}
template <class E>
__device__ __forceinline__ void run_gemm(LAS unsigned char* lds, const bf16_t* A, int lda, int a_pn_off, const bf16_t* Bt, int ldb, int M, int N, int K, const E& e, int G, int bx,
                                         int resc_t = -1, const float* ssa = nullptr, const float* sss = nullptr) {
    Gemm g{A, Bt, M, N, K, lda, ldb, a_pn_off, resc_t, ssa, sss};
    StaticOrder S; S.init(M, N, G, bx);
    EpiW<E> W{e};
    gemm_phase<EpiW<E>>(lds, g, S, W);
}
}

template <class E>
__global__ __launch_bounds__(256) void naive_gemm(const bf16_t* A, int lda, int a_pn_off, const bf16_t* Bt, int ldb, int M, int N, int K, E e, int resc_k, const float* ssa, const float* sss) {
    const int lane = threadIdx.x & 63, wid = threadIdx.x >> 6, fr = lane & 15, fq = lane >> 4;
    const int nct = N / 32, ntask = (M / 64) * nct;
    for (int task = blockIdx.x * 4 + wid; task < ntask; task += gridDim.x * 4) {
        const int rt = task / nct, ct = task % nct, pn = (ct * 32) >> 8;
        const bf16_t* Ab = A + (size_t)pn * a_pn_off + (size_t)(rt * 64 + fr) * lda + fq * 8;
        const bf16_t* Wb0 = Bt + (size_t)(ct * 32 + perm32(fr)) * ldb + fq * 8;
        const bf16_t* Wb1 = Bt + (size_t)(ct * 32 + perm32(16 + fr)) * ldb + fq * 8;
        f32x4 acc[4][2];
#pragma unroll
        for (int m = 0; m < 4; ++m) { acc[m][0] = (f32x4){0, 0, 0, 0}; acc[m][1] = (f32x4){0, 0, 0, 0}; }
        for (int k0 = 0; k0 < K; k0 += 32) {
            if (k0 == resc_k) {
#pragma unroll
                for (int m = 0; m < 4; ++m) { const int row = rt * 64 + m * 16 + fr; const float f = sqrtf((sss[row] * (1.f / 512) + EPS) / (ssa[row] * (1.f / 512) + EPS)); acc[m][0] = acc[m][0] * f; acc[m][1] = acc[m][1] * f; }
            }
            const bf16x8 w0 = *(const bf16x8*)(Wb0 + k0), w1 = *(const bf16x8*)(Wb1 + k0);
#pragma unroll
            for (int m = 0; m < 4; ++m) {
                const bf16x8 a = *(const bf16x8*)(Ab + (size_t)m * 16 * lda + k0);
                acc[m][0] = __builtin_amdgcn_mfma_f32_16x16x32_bf16(w0, a, acc[m][0], 0, 0, 0);
                acc[m][1] = __builtin_amdgcn_mfma_f32_16x16x32_bf16(w1, a, acc[m][1], 0, 0, 0);
            }
        }
        float* tgt = e.ssq(pn);
#pragma unroll
        for (int m = 0; m < 4; ++m) {
            const int row = rt * 64 + m * 16 + fr;
            float s = e(row, ct * 32 + 8 * fq, acc[m][0], acc[m][1]);
            if (tgt) { s += __shfl_xor(s, 16); s += __shfl_xor(s, 32); if (fq == 0) atomicAdd(tgt + row, s); }
        }
    }
}

__global__ __launch_bounds__(256) void naive_attn(const bf16_t* __restrict__ Q, const bf16_t* __restrict__ K, const bf16_t* __restrict__ V, bf16_t* __restrict__ mix, float* __restrict__ ssq_a) {
    const int h = blockIdx.y, row = blockIdx.x * 256 + threadIdx.x;
    const int s0 = row < M_PROMPT ? (blockIdx.x * 256 / SEQ_P) * SEQ_P : M_PROMPT, len = row < M_PROMPT ? SEQ_P : SEQ_S;
    float q[DQK], o[DV];
#pragma unroll
    for (int d = 0; d < DQK; ++d) q[d] = bf2f(Q[(size_t)row * 768 + h * DQK + d]);
#pragma unroll
    for (int d = 0; d < DV; ++d) o[d] = 0.f;
    float m = -1e30f, l = 0.f;
    for (int j = 0; j < len; ++j) {
        const bf16_t* kp = K + (size_t)(s0 + j) * 768 + h * DQK; const bf16_t* vp = V + (size_t)(s0 + j) * 512 + h * DV;
        float s = 0.f;
#pragma unroll
        for (int d = 0; d < DQK; ++d) s += q[d] * bf2f(kp[d]);
        if (s > m) { const float a = exp2f(m - s); l *= a;
#pragma unroll
            for (int d = 0; d < DV; ++d) o[d] *= a;
            m = s; }
        const float p = exp2f(s - m); l += p;
#pragma unroll
        for (int d = 0; d < DV; ++d) o[d] += p * bf2f(vp[d]);
    }
    const float il = 1.f / l; float ss = 0.f;
#pragma unroll
    for (int d = 0; d < DV; ++d) { o[d] *= il; ss += o[d] * o[d]; }
#pragma unroll
    for (int d = 0; d < DV; d += 2) *(unsigned*)(mix + (size_t)row * 1024 + h * DV + d) = pk2(o[d], o[d + 1]);
    atomicAdd(ssq_a + row, ss);
}

__global__ __launch_bounds__(64) void naive_ssm(const bf16_t* __restrict__ ua, float* __restrict__ Y, int dir, const float* lam_re, const float* lam_im, const float* log_dt,
                                                const float* b_re, const float* b_im, const float* c_re, const float* c_im, const float* d_skip) {
    const int n = threadIdx.x, g = blockIdx.x & 31, sq = blockIdx.x >> 5;
    const int s0 = sq < 8 ? sq * SEQ_P : M_PROMPT, len = sq < 8 ? SEQ_P : SEQ_S;
    const int pi = (dir * NG + g) * NS + n;
    const float lr = lam_re[pi], li = lam_im[pi], dt = expf(log_dt[dir * NG + g]);
    const float mag = expf(lr * dt); float sn, cs; sincosf(li * dt, &sn, &cs);
    const float ar = mag * cs, ai = mag * sn;
    const float nr = ar - 1.f, ni = ai, den = lr * lr + li * li;
    const float fr_ = (nr * lr + ni * li) / den, fi_ = (ni * lr - nr * li) / den;
    float bbr[GH], bbi[GH], cr[GH], ci[GH];
#pragma unroll
    for (int h = 0; h < GH; ++h) {
        const float br = b_re[(size_t)pi * GH + h], bi = b_im[(size_t)pi * GH + h];
        bbr[h] = fr_ * br - fi_ * bi; bbi[h] = fr_ * bi + fi_ * br;
        cr[h] = c_re[((size_t)(dir * NG + g) * GH + h) * NS + n]; ci[h] = c_im[((size_t)(dir * NG + g) * GH + h) * NS + n];
    }
    const int hsel = ((n >> 5) & 1) * 8 + ((n >> 4) & 1) * 4 + ((n >> 3) & 1) * 2 + ((n >> 2) & 1);
    float xr = 0.f, xi = 0.f;
    const int nch = len / CT, c0 = s0 / CT;
    for (int cc = 0; cc < nch; ++cc) {
        const int chunk = c0 + (dir == 0 ? cc : nch - 1 - cc);
        const u32x2 raw = *(const u32x2*)(ua + ((size_t)chunk * 32 + g) * 512 + n * 4);
        float uv[4]; uv[0] = __builtin_bit_cast(float, raw.x << 16); uv[1] = __builtin_bit_cast(float, raw.x & 0xffff0000u);
        uv[2] = __builtin_bit_cast(float, raw.y << 16); uv[3] = __builtin_bit_cast(float, raw.y & 0xffff0000u);
#pragma unroll
        for (int tt = 0; tt < CT; ++tt) {
            const int t = dir == 0 ? tt : CT - 1 - tt;
            float u[GH];
#pragma unroll
            for (int h = 0; h < GH; ++h) u[h] = __shfl(uv[h & 3], t * 4 + (h >> 2));
            float bur = 0.f, bui = 0.f;
#pragma unroll
            for (int h = 0; h < GH; ++h) { bur += bbr[h] * u[h]; bui += bbi[h] * u[h]; }
            const float nxr = ar * xr - ai * xi + bur, nxi = ar * xi + ai * xr + bui; xr = nxr; xi = nxi;
            float v[GH];
#pragma unroll
            for (int h = 0; h < GH; ++h) v[h] = cr[h] * xr - ci[h] * xi;
#pragma unroll
            for (int i = 0; i < 8; ++i) { const bool up = n & 32; const float send = up ? v[i] : v[i + 8], keep = up ? v[i + 8] : v[i]; v[i] = keep + __shfl_xor(send, 32); }
#pragma unroll
            for (int i = 0; i < 4; ++i) { const bool up = n & 16; const float send = up ? v[i] : v[i + 4], keep = up ? v[i + 4] : v[i]; v[i] = keep + __shfl_xor(send, 16); }
#pragma unroll
            for (int i = 0; i < 2; ++i) { const bool up = n & 8; const float send = up ? v[i] : v[i + 2], keep = up ? v[i + 2] : v[i]; v[i] = keep + __shfl_xor(send, 8); }
            { const bool up = n & 4; const float send = up ? v[0] : v[1], keep = up ? v[1] : v[0]; v[0] = keep + __shfl_xor(send, 4); }
            v[0] += __shfl_xor(v[0], 2); v[0] += __shfl_xor(v[0], 1);
            if ((n & 3) == 0) {
                float* yp = Y + (size_t)(chunk * CT + t) * SSMW + g * GH + hsel;
                if (dir == 0) *yp = v[0]; else *yp += v[0];
            }
        }
    }
}
__global__ __launch_bounds__(256) void naive_ssm_finish(const float* __restrict__ Y, const bf16_t* __restrict__ ua, const float* __restrict__ d_skip, bf16_t* __restrict__ G) {
    const size_t i = (size_t)blockIdx.x * 256 + threadIdx.x;
    if (i < (size_t)M_TOK * SSMW) {
        const int row = (int)(i >> 9), col = (int)(i & 511), g = col >> 4, h = col & 15;
        const float u = bf2f(ua[((size_t)(row >> 4) * 32 + g) * 512 + (row & 15) * 16 + h]);
        G[i] = (bf16_t)f2bf(gelu_tanh(Y[i] + d_skip[col] * u));
    }
}

__device__ __forceinline__ void final_norm_rows(float* out, const float* ssq_x2, const float* fg, int gw, int ngw, int lane) {
    for (int m = gw; m < M_TOK; m += ngw) {
        const float r = rsqrtf(ssq_x2[m] * (1.f / DM) + EPS);
        f32x4* o = (f32x4*)(out + (size_t)m * DM) + lane;
#pragma unroll
        for (int j = 0; j < 4; ++j) { const f32x4 g = *((const f32x4*)fg + lane + 64 * j); o[64 * j] = o[64 * j] * r * g; }
    }
}
__global__ __launch_bounds__(256) void naive_final(float* out, const float* ssq_x2, const float* fg) {
    final_norm_rows(out, ssq_x2, fg, blockIdx.x * 4 + (threadIdx.x >> 6), gridDim.x * 4, threadIdx.x & 63);
}

constexpr int NWAVES = 8;
template <class MAP>
__device__ __forceinline__ void transpose_item(const float* W, int K, int N, bf16_t* WT, LAS float* scr, int item, int lane, int nblk, const MAP& map, const float* gain0, const float* gain1, int gsplit) {
    const int kb = item / nblk, nb = item % nblk, k0 = 64 * kb, n0 = 32 * nb;
    const int sc = map(n0 + (lane & 31));
#pragma unroll 8
    for (int i = 0; i < 32; ++i) {
        const int kk = 2 * i + (lane >> 5), k = k0 + kk;
        float v = sc >= 0 ? W[(size_t)k * N + sc] : 0.f;
        if (gain0) v *= (k < gsplit ? gain0[k] : gain1[k - gsplit]);
        scr[kk * 33 + (lane & 31)] = v;
    }
    asm volatile("s_waitcnt lgkmcnt(0)" ::: "memory");
    const int c = lane & 7;
#pragma unroll
    for (int j = 0; j < 4; ++j) {
        const int n = (lane >> 3) + 8 * j; const LAS float* s = scr + (8 * c) * 33 + n;
        u32x4 o; o.x = pk2(s[0 * 33], s[1 * 33]); o.y = pk2(s[2 * 33], s[3 * 33]); o.z = pk2(s[4 * 33], s[5 * 33]); o.w = pk2(s[6 * 33], s[7 * 33]);
        *(u32x4*)(WT + (size_t)(n0 + n) * K + k0 + 8 * c) = o;
    }
    asm volatile("s_waitcnt lgkmcnt(0)" ::: "memory");
}
struct MapId { __device__ __forceinline__ int operator()(int n) const { return n; } };
struct MapWin { __device__ __forceinline__ int operator()(int n) const { if (n < 384) return n; if (n < 416) return 384 + rope_logical(n - 384); if (n < 512) return -1; return 416 + (n - 512); } };
struct MapWuq { __device__ __forceinline__ int operator()(int n) const { const int h = n / DQK, d = n % DQK; return h * DQK + (d < DNOPE ? d : DNOPE + rope_logical(d - DNOPE)); } };

struct cpx { float r, i; };
__device__ __forceinline__ cpx cmul(cpx a, cpx b) { return {a.r * b.r - a.i * b.i, a.r * b.i + a.i * b.r}; }
__device__ __forceinline__ cpx apow(float lr, float li, float dt, float p) { const float mag = expf(lr * dt * p); float sn, cs; sincosf(li * dt * p, &sn, &cs); return {mag * cs, mag * sn}; }
__device__ __forceinline__ cpx bfac(float lr, float li, float dt) {
    const cpx a = apow(lr, li, dt, 1.f); const float nr = a.r - 1.f, ni = a.i, den = lr * lr + li * li;
    return {(nr * lr + ni * li) / den, (ni * lr - nr * li) / den};
}

__device__ __forceinline__ void prologue(const Params& p, LAS unsigned char* lds, int vcu, int G) {
    const int tid = threadIdx.x, lane = tid & 63, wave = tid >> 6;
    const int gw = vcu * NWAVES + wave, NGW = G * NWAVES;
    unsigned char* ws = p.ws;
    LAS float* scr = (LAS float*)(lds + wave * 16384);
    {
        constexpr int I_WIN = 16 * 32, I_WUQ = 4 * 24, I_WUKV = 2 * 32, I_WGLU = 8 * 16, I_WOUT = 16 * 32, I_W1 = 16 * 128, I_W2 = 64 * 32;
        constexpr int NITEMS = I_WIN + I_WUQ + I_WUKV + I_WGLU + I_WOUT + I_W1 + I_W2;
        for (int it = gw; it < NITEMS; it += NGW) {
            int r = it;
            if (r < I_WIN) { transpose_item(p.in[3], 1024, INW, (bf16_t*)(ws + WS_WIN), scr, r, lane, 32, MapWin(), p.in[2], p.in[2], 1 << 30); continue; } r -= I_WIN;
            if (r < I_WUQ) { transpose_item(p.in[5], 256, 768, (bf16_t*)(ws + WS_WUQ), scr, r, lane, 24, MapWuq(), p.in[4], p.in[4], 1 << 30); continue; } r -= I_WUQ;
            if (r < I_WUKV) { transpose_item(p.in[7], 128, 1024, (bf16_t*)(ws + WS_WUKV), scr, r, lane, 32, MapId(), p.in[6], p.in[6], 1 << 30); continue; } r -= I_WUKV;
            if (r < I_WGLU) { transpose_item(p.in[16], 512, 512, (bf16_t*)(ws + WS_WGLU), scr, r, lane, 16, MapId(), nullptr, nullptr, 0); continue; } r -= I_WGLU;
            if (r < I_WOUT) { transpose_item(p.in[20], 1024, 1024, (bf16_t*)(ws + WS_WOUT), scr, r, lane, 32, MapId(), p.in[18], p.in[19], 512); continue; } r -= I_WOUT;
            if (r < I_W1) { transpose_item(p.in[22], 1024, 4096, (bf16_t*)(ws + WS_W1), scr, r, lane, 128, MapId(), p.in[21], p.in[21], 1 << 30); continue; } r -= I_W1;
            transpose_item(p.in[23], 4096, 1024, (bf16_t*)(ws + WS_W2), scr, r, lane, 32, MapId(), nullptr, nullptr, 0);
        }
    }
    {
        float* stat = (float*)(ws + WS_STAT); bf16_t* xb = (bf16_t*)(ws + WS_XB);
        for (int m = gw; m < M_TOK; m += NGW) {
            const float* xrow = m < M_PROMPT ? p.in[0] + (size_t)m * DM : p.in[1] + (size_t)(m - M_PROMPT) * DM;
            const f32x4* xr = (const f32x4*)xrow + lane;
            f32x4 v[4]; float s = 0.f;
#pragma unroll
            for (int j = 0; j < 4; ++j) { v[j] = xr[64 * j]; s += (v[j].x * v[j].x + v[j].y * v[j].y) + (v[j].z * v[j].z + v[j].w * v[j].w); }
            s = wave_sum(s);
            unsigned long long* o8 = (unsigned long long*)(xb + (size_t)m * DM) + lane;
#pragma unroll
            for (int j = 0; j < 4; ++j) o8[64 * j] = (unsigned long long)pk2(v[j].x, v[j].y) | ((unsigned long long)pk2(v[j].z, v[j].w) << 32);
            if (lane == 0) stat[ST_RSTD1 * M_TOK + m] = rsqrtf(s * (1.f / DM) + EPS);
            else if (lane < 7) stat[lane * M_TOK + m] = 0.f;
        }
    }
    {
        float* cosT = (float*)(ws + WS_ROPE); float* sinT = cosT + SEQ_S * 16;
        for (int i = gw * 64 + lane; i < SEQ_S * 16; i += NGW * 64) {
            const int pos = i >> 4, j = i & 15;
            const float inv = powf(10000.f, -(float)(2 * j) / 32.f);
            const float ang = (float)pos * inv; float sn, cs; sincosf(ang, &sn, &cs);
            cosT[i] = cs; sinT[i] = sn;
        }
    }
    {
        const float* lam_re = p.in[8]; const float* lam_im = p.in[9]; const float* log_dt = p.in[10];
        const float* b_re = p.in[11]; const float* b_im = p.in[12]; const float* c_re = p.in[13]; const float* c_im = p.in[14]; const float* d_skip = p.in[15];
        bf16_t* MQ = (bf16_t*)(ws + WS_MQ); bf16_t* SP = (bf16_t*)(ws + WS_SP); float* AT = (float*)(ws + WS_AT);
        for (int it = gw; it < NG * CT * 2; it += NGW) {
            const int dir = it & 1, k = (it >> 1) & 15, g = it >> 5;
            if (k == 0 && dir == 1) continue;
            const int h = lane >> 2, hp0 = (lane & 3) * 4;
            float e[4] = {0.f, 0.f, 0.f, 0.f};
            const int ndir = (k == 0) ? 2 : 1;
            for (int dd = 0; dd < ndir; ++dd) {
                const int d = (k == 0) ? dd : dir;
                const int pi = (d * NG + g) * NS + lane;
                const float lr = lam_re[pi], li = lam_im[pi], dt = expf(log_dt[d * NG + g]);
                const cpx coef = cmul(apow(lr, li, dt, (float)k), bfac(lr, li, dt));
                for (int n = 0; n < NS; ++n) {
                    const cpx cf = {__shfl(coef.r, n), __shfl(coef.i, n)};
                    const size_t ci_ = ((size_t)(d * NG + g) * GH + h) * NS + n;
                    const cpx cc = cmul({c_re[ci_], c_im[ci_]}, cf);
                    const size_t bi_ = ((size_t)(d * NG + g) * NS + n) * GH + hp0;
#pragma unroll
                    for (int q = 0; q < 4; ++q) e[q] += cc.r * b_re[bi_ + q] - cc.i * b_im[bi_ + q];
                }
            }
            if (k == 0) {
#pragma unroll
                for (int q = 0; q < 4; ++q) if (hp0 + q == h) e[q] += d_skip[g * GH + h];
            }
            const unsigned long long w = (unsigned long long)pk2(e[0], e[1]) | ((unsigned long long)pk2(e[2], e[3]) << 32);
            for (int t = 0; t < CT; ++t) {
                const int j = (k == 0) ? t : (dir == 0 ? t - k : t + k);
                if (j < 0 || j >= CT) continue;
                *(unsigned long long*)(MQ + ((size_t)g * 256 + t * 16 + h) * 512 + j * 16 + hp0) = w;
            }
        }
        for (int i = gw * 64 + lane; i < NG * 256 * 256; i += NGW * 64) {
            const int s = i & 255, rr = (i >> 8) & 255, g = i >> 16;
            const int dir = s >> 7, part = (s >> 6) & 1, n = s & 63;
            const int pi = (dir * NG + g) * NS + n;
            const float lr = lam_re[pi], li = lam_im[pi], dt = expf(log_dt[dir * NG + g]);
            {
                const int t = rr >> 4, h = rr & 15;
                const cpx a = apow(lr, li, dt, (float)(dir == 0 ? t + 1 : CT - t));
                const size_t ci_ = ((size_t)(dir * NG + g) * GH + h) * NS + n;
                const cpx v = cmul({c_re[ci_], c_im[ci_]}, a);
                MQ[((size_t)g * 256 + rr) * 512 + 256 + s] = (bf16_t)f2bf(part == 0 ? v.r : -v.i);
            }
            {
                const int j = rr >> 4, hp = rr & 15;
                const cpx a = cmul(apow(lr, li, dt, (float)(dir == 0 ? CT - 1 - j : j)), bfac(lr, li, dt));
                const size_t bi_ = ((size_t)(dir * NG + g) * NS + n) * GH + hp;
                const cpx v = cmul(a, {b_re[bi_], b_im[bi_]});
                SP[((size_t)g * 256 + s) * 256 + rr] = (bf16_t)f2bf(part == 0 ? v.r : v.i);
            }
        }
        for (int i = gw * 64 + lane; i < 2 * NG * NS; i += NGW * 64) {
            const float lr = lam_re[i], li = lam_im[i], dt = expf(log_dt[i >> 6]);
            const cpx a = apow(lr, li, dt, (float)CT); AT[2 * i] = a.r; AT[2 * i + 1] = a.i;
        }
    }
}


namespace att {
using s16x4 = __attribute__((ext_vector_type(4))) short;
using f32x16 = __attribute__((ext_vector_type(16))) float;
constexpr int QBLK = 32, KVBLK = 64;
constexpr int SHM_V = KVBLK * DV * 2, SHM_K = KVBLK * 256;
constexpr int NSLOT = 3, OFF_V = 0, OFF_K = NSLOT * SHM_V, OFF_WS = NSLOT * (SHM_V + SHM_K);
constexpr float THRL = 8.f;
#define KSWZ(row, colB) ((row) * 256 + ((colB) ^ (((row) & 7) << 4)))
#define SBAR() __builtin_amdgcn_sched_barrier(0)
__device__ __forceinline__ int crow(int r, int hi) { return (r & 3) + 8 * (r >> 2) + 4 * hi; }
__device__ __forceinline__ unsigned cvtpk(float lo, float hi) { unsigned r; asm volatile("v_cvt_pk_bf16_f32 %0, %1, %2" : "=v"(r) : "v"(lo), "v"(hi)); return r; }
__device__ __forceinline__ void partialSM(f32x16& p0, f32x16& p1, float& m_reg, float& alpha) {
    float pmax = p0[0];
#pragma unroll
    for (int r = 1; r < 16; ++r) pmax = fmaxf(pmax, p0[r]);
#pragma unroll
    for (int r = 0; r < 16; ++r) pmax = fmaxf(pmax, p1[r]);
    { auto rr = __builtin_amdgcn_permlane32_swap(__float_as_uint(pmax), __float_as_uint(pmax), false, false); pmax = fmaxf(__uint_as_float(rr[0]), __uint_as_float(rr[1])); }
    float mn;
    if (__builtin_expect(__all(pmax - m_reg <= THRL), 1)) { mn = m_reg; alpha = 1.f; }
    else { mn = fmaxf(m_reg, pmax); alpha = __builtin_amdgcn_exp2f(m_reg - mn); m_reg = mn; }
#pragma unroll
    for (int r = 0; r < 16; ++r) { p0[r] -= mn; p1[r] -= mn; }
#pragma unroll
    for (int r = 0; r < 16; ++r) p0[r] = __builtin_amdgcn_exp2f(p0[r]);
}
__device__ __forceinline__ void finishSM(f32x16& p0, f32x16& p1, float alpha, float& l_reg, bf16x8& pa0, bf16x8& pa1, bf16x8& pa2, bf16x8& pa3) {
#pragma unroll
    for (int r = 0; r < 16; ++r) p1[r] = __builtin_amdgcn_exp2f(p1[r]);
    float ps = 0;
#pragma unroll
    for (int r = 0; r < 16; ++r) ps += p0[r];
#pragma unroll
    for (int r = 0; r < 16; ++r) ps += p1[r];
    { auto rr = __builtin_amdgcn_permlane32_swap(__float_as_uint(ps), __float_as_uint(ps), false, false); ps = __uint_as_float(rr[0]) + __uint_as_float(rr[1]); }
    l_reg = l_reg * alpha + ps;
#define PK4(P, BASE, OUT) do { unsigned a0 = cvtpk(P[BASE + 0], P[BASE + 1]), a1 = cvtpk(P[BASE + 2], P[BASE + 3]);   \
    unsigned b0 = cvtpk(P[BASE + 4], P[BASE + 5]), b1 = cvtpk(P[BASE + 6], P[BASE + 7]);                              \
    auto r0 = __builtin_amdgcn_permlane32_swap(a0, b0, false, false); auto r1 = __builtin_amdgcn_permlane32_swap(a1, b1, false, false); \
    u32x4 w = {r0[0], r1[0], r0[1], r1[1]}; OUT = __builtin_bit_cast(bf16x8, w); } while (0)
    PK4(p0, 0, pa0); PK4(p0, 8, pa1); PK4(p1, 0, pa2); PK4(p1, 8, pa3);
#undef PK4
}
__device__ __forceinline__ void qkt(f32x16& p0, f32x16& p1, const LAS unsigned char* Ks, const bf16x8* qr, int r32, int hi) {
    p0 = f32x16{}; p1 = f32x16{};
#pragma unroll
    for (int d0 = 0; d0 < DQK / 16; ++d0) { const int cb = (d0 * 16 + hi * 8) * 2;
        const bf16x8 b0 = *(const LAS bf16x8*)(Ks + KSWZ(r32, cb));
        const bf16x8 b1 = *(const LAS bf16x8*)(Ks + KSWZ(32 + r32, cb));
        p0 = __builtin_amdgcn_mfma_f32_32x32x16_bf16(b0, qr[d0], p0, 0, 0, 0);
        p1 = __builtin_amdgcn_mfma_f32_32x32x16_bf16(b1, qr[d0], p1, 0, 0, 0); }
}
__device__ __forceinline__ int v_st(int k, int c) { const int kk = (k & ~0xC) | ((k & 4) << 1) | ((k & 8) >> 1); return ((kk >> 3) * 2 + (c >> 5)) * 512 + ((kk & 7) * 32 + (c & 31)) * 2; }
__device__ __forceinline__ int v_rd_base(int lane) { return ((lane & 3) << 3) | (((lane >> 2) & 3) << 6) | (((lane >> 4) & 1) << 5) | (((lane >> 5) & 1) << 8); }
constexpr int v_rd_off(int d0, int ks, int half) { return d0 * 512 + ks * 2048 + half * 1024; }
template <int OFF> __device__ __forceinline__ s16x4 tr_read(int vb) { s16x4 r; asm volatile("ds_read_b64_tr_b16 %0, %1 offset:%2" : "=&v"(r) : "v"(vb), "i"(OFF) : "memory"); return r; }
template <int D0> __device__ __forceinline__ void pv_one(f32x16& od, int vb, bf16x8 pa0, bf16x8 pa1, bf16x8 pa2, bf16x8 pa3) {
    const s16x4 l0 = tr_read<v_rd_off(D0, 0, 0)>(vb), h0 = tr_read<v_rd_off(D0, 0, 1)>(vb), l1 = tr_read<v_rd_off(D0, 1, 0)>(vb), h1 = tr_read<v_rd_off(D0, 1, 1)>(vb);
    const s16x4 l2 = tr_read<v_rd_off(D0, 2, 0)>(vb), h2 = tr_read<v_rd_off(D0, 2, 1)>(vb), l3 = tr_read<v_rd_off(D0, 3, 0)>(vb), h3 = tr_read<v_rd_off(D0, 3, 1)>(vb);
    asm volatile("s_waitcnt lgkmcnt(0)" ::: "memory"); SBAR();
#define PK(L, H) (bf16x8){L[0], L[1], L[2], L[3], H[0], H[1], H[2], H[3]}
    od = __builtin_amdgcn_mfma_f32_32x32x16_bf16(pa0, PK(l0, h0), od, 0, 0, 0);
    od = __builtin_amdgcn_mfma_f32_32x32x16_bf16(pa1, PK(l1, h1), od, 0, 0, 0);
    od = __builtin_amdgcn_mfma_f32_32x32x16_bf16(pa2, PK(l2, h2), od, 0, 0, 0);
    od = __builtin_amdgcn_mfma_f32_32x32x16_bf16(pa3, PK(l3, h3), od, 0, 0, 0);
#undef PK
}
__device__ __forceinline__ void attn_unit(const bf16_t* __restrict__ Q, const bf16_t* __restrict__ K, const bf16_t* __restrict__ V, bf16_t* __restrict__ MIX, float* __restrict__ ssq_a,
                                          int row0, int h, int s0, int seq, LAS unsigned char* lds) {
    int tid = threadIdx.x; asm volatile("" : "+v"(tid));
    const int wid = tid >> 6, lane = tid & 63, r32 = lane & 31, hi = lane >> 5;
    LAS unsigned char* V_lds = lds + OFF_V; LAS unsigned char* K_lds = lds + OFF_K;
    LAS float* wsf = (LAS float*)(lds + OFF_WS) + wid * 64; LAS float* li_l = wsf; LAS float* al_l = wsf + 32;
    float m_reg = -1e30f, l_reg = 0; f32x16 o[2] = {}; bf16x8 qr[DQK / 16];
    const bf16_t* Qw = Q + (size_t)(row0 + wid * QBLK + r32) * 768 + h * DQK + hi * 8;
#pragma unroll
    for (int d0 = 0; d0 < DQK / 16; ++d0) qr[d0] = *(const bf16x8*)(Qw + d0 * 16);
    const bf16_t* Kh = K + (size_t)s0 * 768 + h * DQK; const bf16_t* Vh = V + (size_t)s0 * 512 + h * DV;
    const int kr0 = tid / 12, kc0 = tid % 12, kr1 = (512 + tid) / 12, kc1 = (512 + tid) % 12, vr = tid >> 3, vc = tid & 7;
    const bool k2 = tid < 256;
    const int kst0 = KSWZ(kr0, kc0 * 16), kst1 = KSWZ(kr1, kc1 * 16), vst = v_st(vr, vc * 8);
    const bf16_t* kg0 = Kh + (size_t)kr0 * 768 + kc0 * 8; const bf16_t* kg1 = Kh + (size_t)kr1 * 768 + kc1 * 8; const bf16_t* vg = Vh + (size_t)vr * 512 + vc * 8;
    const int vb0 = (int)(unsigned)(uintptr_t)V_lds + v_rd_base(lane);
    struct { bf16x8 k0, k1, v; } sr_[2];
#define SLOAD(i, kk0) do { sr_[i].k0 = *(const bf16x8*)(kg0 + (size_t)(kk0) * 768); if (k2) sr_[i].k1 = *(const bf16x8*)(kg1 + (size_t)(kk0) * 768); sr_[i].v = *(const bf16x8*)(vg + (size_t)(kk0) * 512); } while (0)
#define SWRITE(b, i) do { *(LAS bf16x8*)(V_lds + (b) * SHM_V + vst) = sr_[i].v; *(LAS bf16x8*)(K_lds + (b) * SHM_K + kst0) = sr_[i].k0; if (k2) *(LAS bf16x8*)(K_lds + (b) * SHM_K + kst1) = sr_[i].k1; } while (0)
#define RESC(a) do { if (__any((a) < 1.f)) { if (hi == 0) al_l[r32] = (a); asm volatile("s_waitcnt lgkmcnt(0)" ::: "memory"); \
    _Pragma("unroll") for (int d = 0; d < 2; ++d) _Pragma("unroll") for (int r = 0; r < 16; ++r) o[d][r] *= al_l[crow(r, hi)]; } } while (0)
    f32x16 pA0, pA1, pB0, pB1; float alA, alB; bf16x8 pa0, pa1, pa2, pa3; const int NT = seq / KVBLK;
    int sp = 0, sc = 0, sn = 1;
#define ROT() do { sp = sc; sc = sn; sn = (sn == NSLOT - 1) ? 0 : sn + 1; } while (0)
    SLOAD(0, 0); SWRITE(0, 0); SLOAD(1, KVBLK); SLOAD(0, 2 * KVBLK); __syncthreads();
    qkt(pA0, pA1, K_lds, qr, r32, hi); partialSM(pA0, pA1, m_reg, alA);
    SWRITE(1, 1); SLOAD(1, 3 * KVBLK); __syncthreads();
    ROT();
    for (int j = 1; j + 1 < NT; j += 2) {
        SBAR(); qkt(pB0, pB1, K_lds + sc * SHM_K, qr, r32, hi);
        finishSM(pA0, pA1, alA, l_reg, pa0, pa1, pa2, pa3); SBAR();
        SWRITE(sn, 0); if (j + 3 < NT) SLOAD(0, (j + 3) * KVBLK); SBAR();
        pv_one<0>(o[0], vb0 + sp * SHM_V, pa0, pa1, pa2, pa3); pv_one<1>(o[1], vb0 + sp * SHM_V, pa0, pa1, pa2, pa3); partialSM(pB0, pB1, m_reg, alB);
        RESC(alB); __syncthreads(); ROT();
        SBAR(); qkt(pA0, pA1, K_lds + sc * SHM_K, qr, r32, hi);
        finishSM(pB0, pB1, alB, l_reg, pa0, pa1, pa2, pa3); SBAR();
        if (j + 2 < NT) { SWRITE(sn, 1); if (j + 4 < NT) SLOAD(1, (j + 4) * KVBLK); } SBAR();
        pv_one<0>(o[0], vb0 + sp * SHM_V, pa0, pa1, pa2, pa3); pv_one<1>(o[1], vb0 + sp * SHM_V, pa0, pa1, pa2, pa3); partialSM(pA0, pA1, m_reg, alA);
        RESC(alA); __syncthreads(); ROT();
    }
    SBAR(); qkt(pB0, pB1, K_lds + sc * SHM_K, qr, r32, hi);
    finishSM(pA0, pA1, alA, l_reg, pa0, pa1, pa2, pa3); SBAR();
    pv_one<0>(o[0], vb0 + sp * SHM_V, pa0, pa1, pa2, pa3); pv_one<1>(o[1], vb0 + sp * SHM_V, pa0, pa1, pa2, pa3); partialSM(pB0, pB1, m_reg, alB);
    RESC(alB);
    finishSM(pB0, pB1, alB, l_reg, pa0, pa1, pa2, pa3); SBAR();
    pv_one<0>(o[0], vb0 + sc * SHM_V, pa0, pa1, pa2, pa3); pv_one<1>(o[1], vb0 + sc * SHM_V, pa0, pa1, pa2, pa3);
#undef ROT
    if (hi == 0) li_l[r32] = l_reg; asm volatile("s_waitcnt lgkmcnt(0)" ::: "memory");
    bf16_t* Ow = MIX + (size_t)(row0 + wid * QBLK) * 1024 + h * DV;
#pragma unroll
    for (int r = 0; r < 16; ++r) { const int orow = crow(r, hi); const float rl = __builtin_amdgcn_rcpf(li_l[orow]);
        const float a = o[0][r] * rl, b = o[1][r] * rl;
        Ow[(size_t)orow * 1024 + r32] = (bf16_t)f2bf(a); Ow[(size_t)orow * 1024 + 32 + r32] = (bf16_t)f2bf(b);
        float ss = a * a + b * b;
        ss += __shfl_xor(ss, 1); ss += __shfl_xor(ss, 2); ss += __shfl_xor(ss, 4); ss += __shfl_xor(ss, 8); ss += __shfl_xor(ss, 16);
        if (r32 == 0) atomicAdd(ssq_a + row0 + wid * QBLK + orow, ss); }
    __syncthreads();
#undef SLOAD
#undef SWRITE
#undef RESC
}
__device__ __forceinline__ void attn_phase(const bf16_t* Q, const bf16_t* K, const bf16_t* V, bf16_t* MIX, float* ssq_a, int vcu, int G, LAS unsigned char* lds) {
    constexpr int NU = 512 + 1024;
    const int nmine = (G == 256) ? 6 : (NU - vcu + G - 1) / G;
#pragma unroll 1
    for (int i = 0; i < nmine; ++i) {
        int u;
        if (G == 256) { const int x = vcu >> 5, l = vcu & 31; u = (i < 2) ? x * 64 + l + 32 * i : 512 + (8 * x) * 16 + (i - 2) * 32 + l; }
        else u = vcu + i * G;
        int row0, h, s0, seq;
        if (u < 512) { row0 = M_PROMPT + (u & 63) * 256; h = u >> 6; s0 = M_PROMPT; seq = SEQ_S; }
        else { const int pu = u - 512, bh = pu >> 4, qb = pu & 15, b = bh >> 3; h = bh & 7; s0 = b * SEQ_P; row0 = s0 + qb * 256; seq = SEQ_P; }
        attn_unit(Q, K, V, MIX, ssq_a, row0, h, s0, seq, lds);
    }
}
#undef KSWZ
#undef SBAR
}

__device__ __forceinline__ void ssm_scan1(const float* __restrict__ LST, bf16_t* __restrict__ UA, const float* __restrict__ AT, float* __restrict__ ESEG, int vb, int tid) {
    const int r = vb * (NWAVES * 64) + tid;
    if (r >= 12 * 4096) return;
    const int item = r >> 12, rem = r & 4095, dir = rem >> 11, g = (rem >> 6) & 31, n = rem & 63;
    const int c0 = item * 256;
    const float ar = AT[2 * ((dir * NG + g) * NS + n)], ai = AT[2 * ((dir * NG + g) * NS + n) + 1];
    const size_t off = (size_t)g * 256 + dir * 128 + n;
    const int step = dir == 0 ? 1 : -1; const int c = dir == 0 ? c0 : c0 + 255;
    float xr = 0.f, xi = 0.f;
    const float* lp = LST + (size_t)c * 8192 + off;
    bf16_t* up = UA + (size_t)c * 16384 + g * 512 + 256 + dir * 128 + n;
#pragma unroll 1
    for (int b = 0; b < 256; b += 64) {
        int st = step; asm volatile("" : "+v"(st));
        const long ls = (long)st * 8192, us = (long)st * 16384;
        float lr[64], li[64];
#pragma unroll
        for (int k = 0; k < 64; ++k) { lr[k] = lp[0]; li[k] = lp[64]; lp += ls; }
#pragma unroll
        for (int k = 0; k < 64; ++k) {
            up[0] = (bf16_t)f2bf(xr); up[64] = (bf16_t)f2bf(xi); up += us;
            const float tr = ar * xr - ai * xi + lr[k], ti = ar * xi + ai * xr + li[k]; xr = tr; xi = ti;
        }
    }
    if (item >= 8) { float* e = ESEG + ((size_t)(item - 8) * 4096 + rem) * 2; e[0] = xr; e[1] = xi; }
}
__device__ __forceinline__ void ssm_scan2(bf16_t* __restrict__ UA, const float* __restrict__ ESEG, const float* lam_re, const float* lam_im, const float* log_dt, int gtid, int nthr) {
    for (int i = gtid; i < 768 * 4096; i += nthr) {
        const int rem = i & 4095, cc = i >> 12, dir = rem >> 11, g = (rem >> 6) & 31, n = rem & 63;
        const int q = cc >> 8, j = cc & 255, k = dir == 0 ? q + 1 : q;
        const int pi = (dir * NG + g) * NS + n;
        const float lr = lam_re[pi], li = lam_im[pi], dt = expf(log_dt[dir * NG + g]);
        const cpx A = apow(lr, li, dt, (float)(CT * 256));
        cpx carry = {0.f, 0.f};
        if (dir == 0) { for (int kk = 0; kk < k; ++kk) { const float* e = ESEG + ((size_t)kk * 4096 + rem) * 2; const cpx t = cmul(A, carry); carry = {t.r + e[0], t.i + e[1]}; } }
        else { for (int kk = 3; kk > k; --kk) { const float* e = ESEG + ((size_t)kk * 4096 + rem) * 2; const cpx t = cmul(A, carry); carry = {t.r + e[0], t.i + e[1]}; } }
        const cpx f = cmul(apow(lr, li, dt, (float)(CT * (dir == 0 ? j : 255 - j))), carry);
        bf16_t* up = UA + (size_t)(2048 + k * 256 + j) * 16384 + g * 512 + 256 + dir * 128 + n;
        up[0] = (bf16_t)f2bf(bf2f(up[0]) + f.r); up[64] = (bf16_t)f2bf(bf2f(up[64]) + f.i);
    }
}

#define XB_TMO      128
#define XB_XCNT(j)  (256  + 64 * (j))
#define XB_XSUB(j)  (1280 + 64 * (j))
#define XB_XGEN(j)  (2304 + 64 * (j))
#define XB_TOP      3328
#define XB_TOPGEN   3392
#define XCD_BAR_WORDS 3456
#define XB_SPIN_CAP (1u << 22)
__device__ __forceinline__ unsigned xb_ld(unsigned* p)              { return __hip_atomic_load(p, __ATOMIC_RELAXED, __HIP_MEMORY_SCOPE_AGENT); }
__device__ __forceinline__ unsigned xb_add(unsigned* p, unsigned v) { return __hip_atomic_fetch_add(p, v, __ATOMIC_RELAXED, __HIP_MEMORY_SCOPE_AGENT); }
__device__ __forceinline__ unsigned xb_xcc_id() { return (unsigned)__builtin_amdgcn_s_getreg((3 << 11) | 20) & 0xFu; }
#define XB_SPIN(cond, bar) do { unsigned _sp = 0; while (cond) { __builtin_amdgcn_s_sleep(1); \
    if ((++_sp & 255u) == 0u) { if (xb_ld(&(bar)[XB_TMO])) break; if (_sp > XB_SPIN_CAP) { atomicAdd(&(bar)[XB_TMO], 1u); break; } } } } while (0)
struct XcdBarrier { unsigned* bar; unsigned x; volatile LAS unsigned* st; };
__device__ __forceinline__ XcdBarrier xcd_barrier_post(unsigned* bar, volatile LAS unsigned* st) {
    XcdBarrier b; b.bar = bar; b.x = xb_xcc_id(); b.st = st;
    if (threadIdx.x == 0) (void)xb_add(&bar[XB_XCNT(b.x)], 1u);
    return b;
}
__device__ __forceinline__ void xcd_barrier_complete(unsigned* bar, unsigned x, unsigned& nloc, unsigned& nx) {
    const unsigned G = gridDim.x * gridDim.y * gridDim.z;
    unsigned sum, cnt, mine, sp = 0u;
    for (;;) {
        sum = 0u; cnt = 0u; mine = 0u;
#pragma unroll
        for (unsigned j = 0; j < 16; ++j) { const unsigned c = xb_ld(&bar[XB_XCNT(j)]); sum += c; cnt += (c > 0u) ? 1u : 0u; mine = (j == x) ? c : mine; }
        if (sum == G) break;
        __builtin_amdgcn_s_sleep(1);
        if ((++sp & 255u) == 0u) { if (xb_ld(&bar[XB_TMO])) break; if (sp > XB_SPIN_CAP) { atomicAdd(&bar[XB_TMO], 1u); break; } }
    }
    nloc = mine > 0u ? mine : 1u; nx = cnt > 0u ? cnt : 1u;
}
__device__ __forceinline__ void xcd_barrier(const XcdBarrier& b) {
    asm volatile("s_waitcnt vmcnt(0)" ::: "memory");
    __syncthreads();
    if (threadIdx.x == 0) {
        unsigned* bar = b.bar;
        __builtin_amdgcn_s_waitcnt(0);
        unsigned nloc = b.st[0], nx = b.st[1];
        if (nloc == 0u) { xcd_barrier_complete(bar, b.x, nloc, nx); b.st[0] = nloc; b.st[1] = nx; }
        const unsigned old = xb_add(&bar[XB_XSUB(b.x)], 1u);
        const unsigned gen = old / nloc;
        if (old + 1u == (gen + 1u) * nloc) {
            __builtin_amdgcn_fence(__ATOMIC_RELEASE, "agent");
            asm volatile("s_waitcnt vmcnt(0)" ::: "memory");
            const unsigned og = xb_add(&bar[XB_TOP], 1u);
            const unsigned tg = og / nx;
            if (og + 1u == (tg + 1u) * nx) xb_add(&bar[XB_TOPGEN], 1u);
            else XB_SPIN(xb_ld(&bar[XB_TOPGEN]) == tg, bar);
            __builtin_amdgcn_fence(__ATOMIC_ACQUIRE, "agent");
            xb_add(&bar[XB_XGEN(b.x)], 1u);
            asm volatile("s_waitcnt vmcnt(0)" ::: "memory");
        } else {
            XB_SPIN(xb_ld(&bar[XB_XGEN(b.x)]) == gen, bar);
            __builtin_amdgcn_fence(__ATOMIC_ACQUIRE, "agent");
            asm volatile("s_waitcnt vmcnt(0)" ::: "memory");
        }
    }
    __syncthreads();
}

constexpr int LDS_BYTES = 147456, MISC_OFF = 131072 + 320;
constexpr int N_PHASES = 15;
constexpr unsigned PROBE_MASK = 0u;
constexpr int CW_BAR = 4096;
__global__ void __launch_bounds__(NWAVES * 64, 2) mega(Params p) {
    extern __shared__ __attribute__((aligned(16))) unsigned char lds_raw[];
    LAS unsigned char* lds = (LAS unsigned char*)lds_raw;
    const int G = gridDim.x, bx = blockIdx.x, tid = threadIdx.x;
    const int vcu = (G % 8 == 0) ? (bx % 8) * (G / 8) + bx / 8 : bx;
    unsigned char* ws = p.ws;
    volatile LAS unsigned* MISC = (volatile LAS unsigned*)(lds + MISC_OFF);
    for (int u = tid; u < (LDS_BYTES - 131072) / 4; u += NWAVES * 64) ((LAS unsigned*)(lds + 131072))[u] = 0u;
    __syncthreads();
    const int lo = p.ph_lo, hi = p.ph_hi;
    XcdBarrier bar; bar.bar = (unsigned*)(ws + WS_CTL) + CW_BAR; bar.x = 0; bar.st = nullptr;
    if (hi - lo > 1) bar = xcd_barrier_post((unsigned*)(ws + WS_CTL) + CW_BAR, MISC + 8);
#ifndef PH_MASK
#define PH_MASK 0xFFFFu
#endif
#define IN(k) (((PH_MASK >> (k)) & 1u) && lo <= (k) && (k) < hi)
#define SEAM(k) do { if (IN(k) && IN((k) + 1)) xcd_barrier(bar); } while (0)
    float* stat = (float*)(ws + WS_STAT);
    const float* cosT = (const float*)(ws + WS_ROPE); const float* sinT = cosT + SEQ_S * 16;
    bf16_t* PROJ = (bf16_t*)(ws + WS_PROJ); bf16_t* GB = (bf16_t*)(ws + WS_PROJ); bf16_t* UA = (bf16_t*)(ws + WS_UA); bf16_t* X1B = (bf16_t*)(ws + WS_UA);
    bf16_t* XB = (bf16_t*)(ws + WS_XB); float* LST = (float*)(ws + WS_XB); bf16_t* HB = (bf16_t*)(ws + WS_XB); bf16_t* MIX = (bf16_t*)(ws + WS_MIX);
    bf16_t* Qb = (bf16_t*)p.out; bf16_t* Kb = Qb + (size_t)M_TOK * 768; bf16_t* Vb = Kb + (size_t)M_TOK * 768;

#define REPS(k) for (int rep = ((PROBE_MASK >> (k)) & 1u) ? 0 : 1; rep < 2; ++rep)
#define DRYBAR() do { if (rep == 0) xcd_barrier(bar); } while (0)
#define SQ(st_) (rep == 0 ? stat + 7 * M_TOK : stat + (st_) * M_TOK)
    if (IN(0)) REPS(0) { prologue(p, lds, vcu, G); DRYBAR(); } SEAM(0);
    if (IN(1)) REPS(1) { EpiProj e{stat + ST_RSTD1 * M_TOK, PROJ, UA, cosT, sinT, SQ(ST_SSQ), SQ(ST_SSKV)};
        pg8::run_gemm(lds, XB, 1024, 0, (const bf16_t*)(ws + WS_WIN), 1024, M_TOK, 1024, 1024, e, G, bx); DRYBAR(); } SEAM(1);
    if (IN(2)) REPS(2) {
        { EpiQ e{stat + ST_SSQ * M_TOK, Qb, cosT, sinT}; pg8::run_gemm(lds, PROJ, 512, 0, (const bf16_t*)(ws + WS_WUQ), 256, M_TOK, 768, 256, e, G, bx); }
        { EpiKV e{stat + ST_SSKV * M_TOK, PROJ, Kb, Vb}; pg8::run_gemm(lds, PROJ + 256, 512, 0, (const bf16_t*)(ws + WS_WUKV), 128, M_TOK, 1024, 128, e, G, bx); }
        { EpiLst e{LST}; pg8::run_gemm(lds, UA, 16384, 512, (const bf16_t*)(ws + WS_SP), 256, NCHUNK, 8192, 256, e, G, bx); }
        DRYBAR(); } SEAM(2);
    if (IN(3)) REPS(3) { ssm_scan1(LST, UA, (const float*)(ws + WS_AT), (float*)(ws + WS_ESEG), vcu, tid); DRYBAR(); } SEAM(3);
    if (IN(4)) REPS(4) { if (rep == 1) ssm_scan2(UA, (const float*)(ws + WS_ESEG), p.in[8], p.in[9], p.in[10], vcu * (NWAVES * 64) + tid, G * NWAVES * 64);
        att::attn_phase(Qb, Kb, Vb, MIX, SQ(ST_SSA), vcu, G, lds); DRYBAR(); } SEAM(4);
    if (IN(5)) REPS(5) { EpiSsmOut e{GB}; pg8::run_gemm(lds, UA, 16384, 512, (const bf16_t*)(ws + WS_MQ), 512, NCHUNK, 8192, 512, e, G, bx); DRYBAR(); } SEAM(5);
    if (IN(6)) REPS(6) { EpiGlu e{GB, p.in[17], MIX, SQ(ST_SSS)}; pg8::run_gemm(lds, GB, 512, 0, (const bf16_t*)(ws + WS_WGLU), 512, M_TOK, 512, 512, e, G, bx); DRYBAR(); } SEAM(6);
    if (IN(7)) REPS(7) { EpiOut e{p.in[0], p.in[1], stat + ST_SSS * M_TOK, p.out, X1B, SQ(ST_SSX1)};
        pg8::run_gemm(lds, MIX, 1024, 0, (const bf16_t*)(ws + WS_WOUT), 1024, M_TOK, 1024, 1024, e, G, bx, 8, stat + ST_SSA * M_TOK, stat + ST_SSS * M_TOK); DRYBAR(); } SEAM(7);
#pragma unroll 1
    for (int th = 0; th < 3; ++th) {
        const int r0 = th * 16384;
        if (IN(8 + 2 * th)) REPS(8) { EpiMlp1 e{stat + ST_SSX1 * M_TOK, HB, r0, 0};
            pg8::run_gemm(lds, X1B + (size_t)r0 * DM, 1024, 0, (const bf16_t*)(ws + WS_W1), 1024, 16384, 4096, 1024, e, G, bx); DRYBAR(); } SEAM(8 + 2 * th);
        if (IN(9 + 2 * th)) REPS(9) { EpiMlp2 e{p.out + (size_t)r0 * DM, rep == 0 ? (float*)(ws + WS_END) : p.out + (size_t)r0 * DM, (rep == 0 ? stat + 7 * M_TOK : stat + ST_SSX2 * M_TOK) + r0, r0, 0};
            pg8::run_gemm(lds, HB, 4096, 0, (const bf16_t*)(ws + WS_W2), 4096, 16384, 1024, 4096, e, G, bx); DRYBAR(); } SEAM(9 + 2 * th);
    }
    if (IN(14)) final_norm_rows(p.out, stat + ST_SSX2 * M_TOK, p.in[24], vcu * NWAVES + (tid >> 6), G * NWAVES, tid & 63);
#undef REPS
#undef DRYBAR
#undef SQ
#undef IN
#undef SEAM
}

extern "C" void kernel_launch(void* const* d_in, const int* in_sizes, int n_in, void* d_out, int out_size, void* d_ws, size_t ws_size, hipStream_t stream) {
    static int ok = 0;
    if (ok == 0) {
        if (n_in != 25 || out_size != M_TOK * DM || ws_size < WS_END + 64 * MiB) { fprintf(stderr, "kernel_launch: unexpected shapes n_in %d out %d ws %zu\n", n_in, out_size, ws_size); ok = -1; return; }
        if (hipFuncSetAttribute((const void*)mega, hipFuncAttributeMaxDynamicSharedMemorySize, LDS_BYTES) != hipSuccess) { fprintf(stderr, "kernel_launch: LDS attribute failed\n"); ok = -1; return; }
        ok = 1;
    }
    if (ok < 0) return;
    Params p{};
    for (int i = 0; i < 25; ++i) p.in[i] = (const float*)d_in[i];
    p.out = (float*)d_out; p.ws = (unsigned char*)d_ws;
    unsigned char* ws = (unsigned char*)d_ws;
    float* stat = (float*)(ws + WS_STAT);
    const float* cosT = (const float*)(ws + WS_ROPE); const float* sinT = cosT + SEQ_S * 16;
    bf16_t* PROJ = (bf16_t*)(ws + WS_PROJ); bf16_t* GB = (bf16_t*)(ws + WS_PROJ); bf16_t* UA = (bf16_t*)(ws + WS_UA); bf16_t* X1B = (bf16_t*)(ws + WS_UA);
    bf16_t* XB = (bf16_t*)(ws + WS_XB); float* YB = (float*)(ws + WS_XB); bf16_t* HB = (bf16_t*)(ws + WS_XB); bf16_t* MIX = (bf16_t*)(ws + WS_MIX);
    bf16_t* Qb = (bf16_t*)d_out; bf16_t* Kb = Qb + (size_t)M_TOK * 768; bf16_t* Vb = Kb + (size_t)M_TOK * 768;
    (void)hipMemsetAsync(ws + WS_CTL, 0, 1 * MiB, stream);
#define MEGA(a, b) do { p.ph_lo = (a); p.ph_hi = (b); hipLaunchKernelGGL(mega, dim3(256), dim3(512), LDS_BYTES, stream, p); } while (0)
    MEGA(0, N_PHASES);
#undef MEGA
}
```

```cpp
#include <hip/hip_runtime.h>
#include <cstdint>
#include <cstdio>

typedef unsigned short bf16_t;
typedef short bf16x8 __attribute__((ext_vector_type(8)));
typedef float f32x4 __attribute__((ext_vector_type(4)));
typedef float f32x2 __attribute__((ext_vector_type(2)));
typedef unsigned u32x4 __attribute__((ext_vector_type(4)));
typedef unsigned u32x2 __attribute__((ext_vector_type(2)));
#define LAS __attribute__((address_space(3)))

constexpr int DM = 1024, M_TOK = 49152, M_PROMPT = 32768, SEQ_P = 4096, SEQ_S = 16384;
constexpr int NH = 8, DQK = 96, DNOPE = 64, DROPE = 32, DV = 64, QR = 256, KVR = 128;
constexpr int SSMW = 512, NG = 32, GH = 16, NS = 64, DFF = 4096, INW = 928;
constexpr int CT = 16, NCHUNK = M_TOK / CT;
constexpr float EPS = 1e-6f;
constexpr float QSCALE = 0.10206207261596575f * 1.4426950408889634f;

constexpr size_t MiB = 1u << 20;
constexpr size_t WS_CTL = 0;
constexpr size_t WS_WIN = 1 * MiB;
constexpr size_t WS_WUQ = 3 * MiB;
constexpr size_t WS_WUKV = 3 * MiB + 384 * 1024;
constexpr size_t WS_WGLU = 4 * MiB;
constexpr size_t WS_WOUT = 5 * MiB;
constexpr size_t WS_W1 = 7 * MiB;
constexpr size_t WS_W2 = 15 * MiB;
constexpr size_t WS_MQ = 23 * MiB;
constexpr size_t WS_SP = 31 * MiB;
constexpr size_t WS_ROPE = 35 * MiB;
constexpr size_t WS_STAT = 37 * MiB;
constexpr size_t WS_AT = 39 * MiB;
constexpr size_t WS_ESEG = 39 * MiB + 64 * 1024;
constexpr size_t WS_PROJ = 40 * MiB;
constexpr size_t WS_UA = 88 * MiB;
constexpr size_t WS_XB = 184 * MiB;
constexpr size_t WS_MIX = 312 * MiB;
constexpr size_t WS_END = 408 * MiB;
enum { ST_RSTD1 = 0, ST_SSQ = 1, ST_SSKV = 2, ST_SSA = 3, ST_SSS = 4, ST_SSX1 = 5, ST_SSX2 = 6 };

struct Params {
    const float* in[25];
    float* out;
    unsigned char* ws;
    int ph_lo, ph_hi;
};

__device__ __forceinline__ unsigned f2bf(float f) { unsigned u = __builtin_bit_cast(unsigned, f); return (u + 0x7fffu + ((u >> 16) & 1u)) >> 16; }
__device__ __forceinline__ unsigned pk2(float lo, float hi) { return f2bf(lo) | (f2bf(hi) << 16); }
__device__ __forceinline__ float bf2f(unsigned short b) { return __builtin_bit_cast(float, (unsigned)b << 16); }
__device__ __forceinline__ void store8bf(bf16_t* p, f32x4 a, f32x4 b) {
    u32x4 w; w.x = pk2(a[0], a[1]); w.y = pk2(a[2], a[3]); w.z = pk2(b[0], b[1]); w.w = pk2(b[2], b[3]); *(u32x4*)p = w;
}
__device__ __forceinline__ void load8bf(const bf16_t* p, f32x4& a, f32x4& b) {
    const u32x4 w = *(const u32x4*)p;
    a[0] = __builtin_bit_cast(float, w.x << 16); a[1] = __builtin_bit_cast(float, w.x & 0xffff0000u);
    a[2] = __builtin_bit_cast(float, w.y << 16); a[3] = __builtin_bit_cast(float, w.y & 0xffff0000u);
    b[0] = __builtin_bit_cast(float, w.z << 16); b[1] = __builtin_bit_cast(float, w.z & 0xffff0000u);
    b[2] = __builtin_bit_cast(float, w.w << 16); b[3] = __builtin_bit_cast(float, w.w & 0xffff0000u);
}
__device__ __forceinline__ float sumsq8(f32x4 a, f32x4 b) { return (a[0] * a[0] + a[1] * a[1]) + (a[2] * a[2] + a[3] * a[3]) + (b[0] * b[0] + b[1] * b[1]) + (b[2] * b[2] + b[3] * b[3]); }
__device__ __forceinline__ int rope_logical(int p) { const int i = p & 7, gq = p >> 3; return i < 4 ? 4 * gq + i : 16 + 4 * gq + (i - 4); }
__device__ __forceinline__ int tok_pos(int row) { return row < M_PROMPT ? (row & (SEQ_P - 1)) : row - M_PROMPT; }
__device__ __forceinline__ int perm32(int rho) { const int n = rho >> 4, i = rho & 15; return 8 * (i >> 2) + 4 * n + (i & 3); }
__device__ __forceinline__ float wave_sum(float v) {
#pragma unroll
    for (int o = 1; o < 64; o <<= 1) v += __shfl_xor(v, o);
    return v;
}
__device__ __forceinline__ float gelu_tanh(float x) {
    const float z = 0.7978845608028654f * (x + 0.044715f * x * x * x);
    const float e = __expf(2.f * z);
    const float th = 1.f - 2.f / (1.f + e);
    return 0.5f * x * (1.f + th);
}

struct EpiProj {
    const float* rstd1; bf16_t* proj; bf16_t* ua; const float* cosT; const float* sinT; float* ssq_q; float* ssq_kv;
    __device__ __forceinline__ float* ssq(int pn) const { return pn == 0 ? ssq_q : (pn == 1 ? ssq_kv : nullptr); }
    __device__ __forceinline__ float operator()(int row, int col, f32x4 v0, f32x4 v1) const {
        const float r = rstd1[row]; v0 = v0 * r; v1 = v1 * r;
        if (col < 384) { store8bf(proj + (size_t)row * 512 + col, v0, v1); return sumsq8(v0, v1); }
        if (col < 416) {
            const int pos = tok_pos(row), gq = (col - 384) >> 3;
            const f32x4 c = *(const f32x4*)(cosT + pos * 16 + gq * 4), s = *(const f32x4*)(sinT + pos * 16 + gq * 4);
            const f32x4 o1 = v0 * c - v1 * s, o2 = v1 * c + v0 * s;
            store8bf(proj + (size_t)row * 512 + col, o1, o2); return 0.f;
        }
        if (col < 512) return 0.f;
        const int c2 = col - 512, g = c2 >> 4, h0 = c2 & 15, chunk = row >> 4, t = row & 15;
        store8bf(ua + ((size_t)chunk * 32 + g) * 512 + t * 16 + h0, v0, v1); return 0.f;
    }
};
struct EpiQ {
    const float* ssq_q; bf16_t* q; const float* cosT; const float* sinT;
    __device__ __forceinline__ float* ssq(int) const { return nullptr; }
    __device__ __forceinline__ float operator()(int row, int col, f32x4 v0, f32x4 v1) const {
        const float r = rsqrtf(ssq_q[row] * (1.f / QR) + EPS); v0 = v0 * r; v1 = v1 * r;
        const int d = col % DQK;
        if (d >= DNOPE) {
            const int pos = tok_pos(row), gq = (d - DNOPE) >> 3;
            const f32x4 c = *(const f32x4*)(cosT + pos * 16 + gq * 4), s = *(const f32x4*)(sinT + pos * 16 + gq * 4);
            const f32x4 o1 = v0 * c - v1 * s, o2 = v1 * c + v0 * s; v0 = o1; v1 = o2;
        }
        store8bf(q + (size_t)row * 768 + col, v0 * QSCALE, v1 * QSCALE); return 0.f;
    }
};
struct EpiKV {
    const float* ssq_kv; const bf16_t* proj; bf16_t* k; bf16_t* v;
    __device__ __forceinline__ float* ssq(int) const { return nullptr; }
    __device__ __forceinline__ float operator()(int row, int col, f32x4 v0, f32x4 v1) const {
        const float r = rsqrtf(ssq_kv[row] * (1.f / KVR) + EPS); v0 = v0 * r; v1 = v1 * r;
        const int h = col >> 7, w = col & 127;
        if (w < 64) {
            store8bf(k + (size_t)row * 768 + h * DQK + w, v0, v1);
            if (w < 32) *(u32x4*)(k + (size_t)row * 768 + h * DQK + 64 + w) = *(const u32x4*)(proj + (size_t)row * 512 + 384 + w);
        } else store8bf(v + (size_t)row * 512 + h * DV + (w - 64), v0, v1);
        return 0.f;
    }
};
struct EpiLst {
    float* lst;
    __device__ __forceinline__ float* ssq(int) const { return nullptr; }
    __device__ __forceinline__ float operator()(int row, int col, f32x4 v0, f32x4 v1) const {
        float* o = lst + (size_t)row * 8192 + col; *(f32x4*)o = v0; *(f32x4*)(o + 4) = v1; return 0.f;
    }
};
struct EpiSsmOut {
    bf16_t* g;
    __device__ __forceinline__ float* ssq(int) const { return nullptr; }
    __device__ __forceinline__ float operator()(int row, int col, f32x4 v0, f32x4 v1) const {
        const int grp = col >> 8, t = (col >> 4) & 15, h0 = col & 15;
#pragma unroll
        for (int i = 0; i < 4; ++i) { v0[i] = gelu_tanh(v0[i]); v1[i] = gelu_tanh(v1[i]); }
        store8bf(g + ((size_t)row * 16 + t) * 512 + grp * 16 + h0, v0, v1); return 0.f;
    }
};
struct EpiGlu {
    const bf16_t* g; const float* bias; bf16_t* mix; float* ssq_s;
    __device__ __forceinline__ float* ssq(int) const { return ssq_s; }
    __device__ __forceinline__ float operator()(int row, int col, f32x4 v0, f32x4 v1) const {
        f32x4 g0, g1; load8bf(g + (size_t)row * 512 + col, g0, g1);
        const f32x4 b0 = *(const f32x4*)(bias + col), b1 = *(const f32x4*)(bias + col + 4);
#pragma unroll
        for (int i = 0; i < 4; ++i) { v0[i] = g0[i] / (1.f + __expf(-(v0[i] + b0[i]))); v1[i] = g1[i] / (1.f + __expf(-(v1[i] + b1[i]))); }
        store8bf(mix + (size_t)row * 1024 + 512 + col, v0, v1); return sumsq8(v0, v1);
    }
};
struct EpiOut {
    const float* xp; const float* xs; const float* ssq_s; float* x1; bf16_t* x1b; float* ssq_x1;
    __device__ __forceinline__ float* ssq(int) const { return ssq_x1; }
    __device__ __forceinline__ float operator()(int row, int col, f32x4 v0, f32x4 v1) const {
        const float r = rsqrtf(ssq_s[row] * (1.f / 512) + EPS);
        const float* xr = (row < M_PROMPT ? xp + (size_t)row * DM : xs + (size_t)(row - M_PROMPT) * DM) + col;
        v0 = *(const f32x4*)xr + v0 * r; v1 = *(const f32x4*)(xr + 4) + v1 * r;
        float* o = x1 + (size_t)row * DM + col; *(f32x4*)o = v0; *(f32x4*)(o + 4) = v1;
        store8bf(x1b + (size_t)row * DM + col, v0, v1); return sumsq8(v0, v1);
    }
};
struct EpiMlp1 {
    const float* ssq_x1; bf16_t* hb; int r0, pad;
    __device__ __forceinline__ float* ssq(int) const { return nullptr; }
    __device__ __forceinline__ float operator()(int row, int col, f32x4 v0, f32x4 v1) const {
        const float r = rsqrtf(ssq_x1[r0 + row] * (1.f / DM) + EPS);
#pragma unroll
        for (int i = 0; i < 4; ++i) { float a = fmaxf(v0[i] * r, 0.f), b = fmaxf(v1[i] * r, 0.f); v0[i] = a * a; v1[i] = b * b; }
        store8bf(hb + (size_t)row * DFF + col, v0, v1); return 0.f;
    }
};
struct EpiMlp2 {
    const float* xin; float* xout; float* ssq_x2; int r0, pad;
    __device__ __forceinline__ float* ssq(int) const { return ssq_x2; }
    __device__ __forceinline__ float operator()(int row, int col, f32x4 v0, f32x4 v1) const {
        const float* i = xin + (size_t)row * DM + col; float* o = xout + (size_t)row * DM + col;
        v0 = *(const f32x4*)i + v0; v1 = *(const f32x4*)(i + 4) + v1;
        *(f32x4*)o = v0; *(f32x4*)(o + 4) = v1; return sumsq8(v0, v1);
    }
};


namespace pg8 {
constexpr int BM = 256, BK = 64, HALF = 128, HTB = HALF * BK * 2, STAGE_BYTES = 8 * HTB, NXCD = 8, WGM = 8;
__host__ __device__ __forceinline__ int lds_byte(int r, int c) { const int st = (r >> 4) * 2 + (c >> 5), rr = r & 15, cc = c & 31, ob = rr * 64 + cc * 2; return st * 1024 + (ob ^ (((ob >> 9) & 1) << 5)); }
__host__ __device__ __forceinline__ void stage_rc(int b, int& R, int& C) { const int st = b / 1024, sb = b % 1024, swz = sb ^ (((sb >> 9) & 1) << 5); R = (st >> 1) * 16 + swz / 64; C = (st & 1) * 32 + (swz % 64) / 2; }
struct Unit { int pm, pn; };
struct Gemm { const bf16_t* A; const bf16_t* Bt; int M, N, K, lda, ldb, a_pn_off, resc_t; const float* ssa; const float* sss; };
struct StaticOrder {
    int nM, nN, nwg, G, c;
    __device__ void init(int M, int N, int G_, int c_) { nM = M / BM; nN = N / BM; nwg = nM * nN; G = G_; c = c_; }
    __device__ bool next(int i, Unit& u) const {
        const long L = (long)i * G + c; if (L >= nwg) return false;
        int wgid = (int)L; { const int q = nwg / NXCD, r = nwg % NXCD, xcd = wgid % NXCD, off = wgid / NXCD; wgid = (xcd < r ? xcd * (q + 1) : r * (q + 1) + (xcd - r) * q) + off; }
        const int nig = WGM * nN, gid = wgid / nig, fm = gid * WGM, gsz = (nM - fm) < WGM ? (nM - fm) : WGM;
        u.pm = fm + ((wgid % nig) % gsz); u.pn = (wgid % nig) / gsz; return true;
    }
};
template <class E> struct EpiW {
    E e;
    __device__ __forceinline__ void operator()(const f32x4 (&acc)[2][2][4][2], const Unit& u, int wr, int wc, int fr, int fq) const {
        float* tgt = e.ssq(u.pn);
#pragma unroll
        for (int ai = 0; ai < 2; ++ai)
#pragma unroll
            for (int m = 0; m < 4; ++m) {
                int row = u.pm * BM + ai * HALF + wr * 64 + m * 16 + fr; asm volatile("" : "+v"(row)); float s = 0.f;
#pragma unroll
                for (int bj = 0; bj < 2; ++bj) s += e(row, u.pn * BM + bj * HALF + wc * 32 + 8 * fq, acc[ai][bj][m][0], acc[ai][bj][m][1]);
                if (tgt) { s += __shfl_xor(s, 16); s += __shfl_xor(s, 32); if (fq == 0) atomicAdd(tgt + row, s); }
                asm volatile("" ::: "memory");
            }
    }
};
template <class Epi>
__device__ __forceinline__ void gemm_phase(LAS unsigned char* lds, const Gemm g, const StaticOrder& S, const Epi& E) {
    int tid = threadIdx.x; asm volatile("" : "+v"(tid));
    const int wid = __builtin_amdgcn_readfirstlane(tid >> 6), lane = tid & 63, wr = wid >> 2, wc = wid & 3, fr = lane & 15, fq = lane >> 4;
    const int K = g.K, nt = K / BK;
    unsigned voffA[2], voffB[2];
#pragma unroll
    for (int i = 0; i < 2; ++i) { int R, C; stage_rc(tid * 16 + i * 8192, R, C); const int Rb = (R & ~31) + perm32(R & 31);
        voffA[i] = (unsigned)(R * g.lda + C) * 2u; voffB[i] = (unsigned)(Rb * g.ldb + C) * 2u; }
    const size_t kstep = (size_t)(BK * 2);
    const size_t hstepA = (size_t)HALF * g.lda * 2, hstepB = (size_t)HALF * g.ldb * 2;
    const size_t tstepA = 2 * hstepA, tstepB = 2 * hstepB, pstepA = (size_t)g.a_pn_off * 2;
    const unsigned ldsw = (unsigned)wid * 1024u;
    const int aoff = lds_byte(wr * 64 + fr, fq * 8), boff = lds_byte(wc * 32 + fr, fq * 8);
#define PG8_SA(b, h) (((b) * 2 + (h)) * HTB)
#define PG8_SB(b, h) ((4 + (b) * 2 + (h)) * HTB)
#define PG8_STAGE(bufoff, gbase, voff) do { _Pragma("unroll") for (int _i = 0; _i < 2; ++_i) \
        __builtin_amdgcn_global_load_lds((const unsigned*)((const char*)(gbase) + (voff)[_i]), (LAS unsigned*)(lds + (bufoff) + ldsw + _i * 8192), 16, 0, 0); } while (0)
#define PG8_LDA(dst, b, h) do { _Pragma("unroll") for (int m = 0; m < 4; ++m) _Pragma("unroll") for (int k = 0; k < 2; ++k) dst[m][k] = *(const LAS bf16x8*)(lds + PG8_SA(b, h) + aoff + m * 2048 + k * 1024); } while (0)
#define PG8_LDB(dst, b, h) do { _Pragma("unroll") for (int n = 0; n < 2; ++n) _Pragma("unroll") for (int k = 0; k < 2; ++k) dst[n][k] = *(const LAS bf16x8*)(lds + PG8_SB(b, h) + boff + n * 2048 + k * 1024); } while (0)
#define PG8_MMA(ai, bj, At, Bt) do { __builtin_amdgcn_s_setprio(1); _Pragma("unroll") for (int m = 0; m < 4; ++m) _Pragma("unroll") for (int n = 0; n < 2; ++n) _Pragma("unroll") for (int k = 0; k < 2; ++k) \
        acc[ai][bj][m][n] = __builtin_amdgcn_mfma_f32_16x16x32_bf16(Bt[n][k], At[m][k], acc[ai][bj][m][n], 0, 0, 0); __builtin_amdgcn_s_setprio(0); } while (0)
#define PG8_WAIT_V(n) asm volatile("s_waitcnt vmcnt(" #n ")" ::: "memory")
#define PG8_WAIT_L(n) asm volatile("s_waitcnt lgkmcnt(" #n ")" ::: "memory")
#define PG8_BAR __builtin_amdgcn_s_barrier()
#define PG8_SCHED __builtin_amdgcn_sched_barrier(0)
    Unit cur, nxt; int ui = 0;
    if (!S.next(0, cur)) return;
    f32x4 acc[2][2][4][2];
#pragma unroll
    for (int a = 0; a < 2; ++a)
#pragma unroll
        for (int b = 0; b < 2; ++b)
#pragma unroll
            for (int m = 0; m < 4; ++m)
#pragma unroll
                for (int n = 0; n < 2; ++n) acc[a][b][m][n] = (f32x4){0.f, 0.f, 0.f, 0.f};
    bf16x8 At[4][2], B0[2][2], B1[2][2];
    const char* cA = (const char*)g.A + (size_t)cur.pm * tstepA + (size_t)cur.pn * pstepA; const char* cB = (const char*)g.Bt + (size_t)cur.pn * tstepB;
    PG8_STAGE(PG8_SB(0, 0), cB, voffB); PG8_STAGE(PG8_SB(0, 1), cB + hstepB, voffB); PG8_STAGE(PG8_SA(0, 0), cA, voffA); PG8_STAGE(PG8_SA(0, 1), cA + hstepA, voffA);
    if (wr == 1) PG8_BAR;
    PG8_WAIT_V(2); PG8_BAR;
    PG8_STAGE(PG8_SB(1, 0), cB + kstep, voffB); PG8_STAGE(PG8_SA(1, 0), cA + kstep, voffA); PG8_STAGE(PG8_SB(1, 1), cB + hstepB + kstep, voffB);
    PG8_WAIT_V(6); PG8_BAR;
    for (;;) {
        const bool has_next = S.next(ui + 1, nxt);
        const char* nA = has_next ? (const char*)g.A + (size_t)nxt.pm * tstepA + (size_t)nxt.pn * pstepA : cA; const char* nB = has_next ? (const char*)g.Bt + (size_t)nxt.pn * tstepB : cB;
        for (int t = 0; t < nt; t += 2) {
            const bool last = (t == nt - 2);
            const char* a1 = cA + (size_t)(t + 1) * kstep;
            const char* a2 = last ? nA : cA + (size_t)(t + 2) * kstep; const char* b2 = last ? nB : cB + (size_t)(t + 2) * kstep;
            const char* a3 = a2 + kstep; const char* b3 = b2 + kstep;
            if (t == g.resc_t) {
#pragma unroll
                for (int ai = 0; ai < 2; ++ai)
#pragma unroll
                    for (int m = 0; m < 4; ++m) { int row = cur.pm * BM + ai * HALF + wr * 64 + m * 16 + fr; asm volatile("" : "+v"(row));
                        const float f = sqrtf((g.sss[row] * (1.f / 512) + EPS) / (g.ssa[row] * (1.f / 512) + EPS));
#pragma unroll
                        for (int bj = 0; bj < 2; ++bj) { acc[ai][bj][m][0] = acc[ai][bj][m][0] * f; acc[ai][bj][m][1] = acc[ai][bj][m][1] * f; }
                        asm volatile("" ::: "memory"); }
            }
            PG8_LDB(B0, 0, 0); PG8_LDB(B1, 0, 1); PG8_SCHED; PG8_LDA(At, 0, 0); PG8_STAGE(PG8_SA(1, 1), a1 + hstepA, voffA);
            PG8_WAIT_V(8); PG8_WAIT_L(0); PG8_BAR; PG8_MMA(0, 0, At, B0); PG8_MMA(0, 1, At, B1); PG8_BAR; PG8_SCHED;
            PG8_LDA(At, 0, 1); PG8_STAGE(PG8_SB(0, 0), b2, voffB); PG8_STAGE(PG8_SB(0, 1), b2 + hstepB, voffB); PG8_STAGE(PG8_SA(0, 0), a2, voffA);
            PG8_WAIT_V(8); PG8_WAIT_L(0); PG8_BAR; PG8_MMA(1, 0, At, B0); PG8_MMA(1, 1, At, B1); PG8_BAR; PG8_SCHED;
            PG8_LDB(B0, 1, 0); PG8_LDB(B1, 1, 1); PG8_SCHED; PG8_LDA(At, 1, 0); PG8_STAGE(PG8_SA(0, 1), a2 + hstepA, voffA);
            PG8_WAIT_V(8); PG8_WAIT_L(0); PG8_BAR; PG8_MMA(0, 0, At, B0); PG8_MMA(0, 1, At, B1); PG8_BAR; PG8_SCHED;
            PG8_LDA(At, 1, 1); PG8_STAGE(PG8_SB(1, 0), b3, voffB); PG8_STAGE(PG8_SB(1, 1), b3 + hstepB, voffB); PG8_STAGE(PG8_SA(1, 0), a3, voffA);
            PG8_WAIT_V(8); PG8_WAIT_L(0); PG8_BAR; PG8_MMA(1, 0, At, B0); PG8_MMA(1, 1, At, B1); PG8_BAR; PG8_SCHED;
        }
        if (wr == 0) PG8_BAR;
        E(acc, cur, wr, wc, fr, fq);
        if (!has_next) break;
#pragma unroll
        for (int a = 0; a < 2; ++a)
#pragma unroll
            for (int b = 0; b < 2; ++b)
#pragma unroll
                for (int m = 0; m < 4; ++m)
#pragma unroll
                    for (int n = 0; n < 2; ++n) acc[a][b][m][n] = (f32x4){0.f, 0.f, 0.f, 0.f};
        cur = nxt; cA = nA; cB = nB; ++ui;
        if (wr == 1) PG8_BAR;
    }
    PG8_WAIT_V(0);
    PG8_BAR;
#undef PG8_SA
#undef PG8_SB
#undef PG8_STAGE
#undef PG8_LDA
#undef PG8_LDB
#undef PG8_MMA
#undef PG8_WAIT_V
#undef PG8_WAIT_L
#undef PG8_BAR
#undef PG8_SCHED
}
template <class E>
__device__ __forceinline__ void run_gemm(LAS unsigned char* lds, const bf16_t* A, int lda, int a_pn_off, const bf16_t* Bt, int ldb, int M, int N, int K, const E& e, int G, int bx,
                                         int resc_t = -1, const float* ssa = nullptr, const float* sss = nullptr) {
    Gemm g{A, Bt, M, N, K, lda, ldb, a_pn_off, resc_t, ssa, sss};
    StaticOrder S; S.init(M, N, G, bx);
    EpiW<E> W{e};
    gemm_phase<EpiW<E>>(lds, g, S, W);
}
}

template <class E>
__global__ __launch_bounds__(256) void naive_gemm(const bf16_t* A, int lda, int a_pn_off, const bf16_t* Bt, int ldb, int M, int N, int K, E e, int resc_k, const float* ssa, const float* sss) {
    const int lane = threadIdx.x & 63, wid = threadIdx.x >> 6, fr = lane & 15, fq = lane >> 4;
    const int nct = N / 32, ntask = (M / 64) * nct;
    for (int task = blockIdx.x * 4 + wid; task < ntask; task += gridDim.x * 4) {
        const int rt = task / nct, ct = task % nct, pn = (ct * 32) >> 8;
        const bf16_t* Ab = A + (size_t)pn * a_pn_off + (size_t)(rt * 64 + fr) * lda + fq * 8;
        const bf16_t* Wb0 = Bt + (size_t)(ct * 32 + perm32(fr)) * ldb + fq * 8;
        const bf16_t* Wb1 = Bt + (size_t)(ct * 32 + perm32(16 + fr)) * ldb + fq * 8;
        f32x4 acc[4][2];
#pragma unroll
        for (int m = 0; m < 4; ++m) { acc[m][0] = (f32x4){0, 0, 0, 0}; acc[m][1] = (f32x4){0, 0, 0, 0}; }
        for (int k0 = 0; k0 < K; k0 += 32) {
            if (k0 == resc_k) {
#pragma unroll
                for (int m = 0; m < 4; ++m) { const int row = rt * 64 + m * 16 + fr; const float f = sqrtf((sss[row] * (1.f / 512) + EPS) / (ssa[row] * (1.f / 512) + EPS)); acc[m][0] = acc[m][0] * f; acc[m][1] = acc[m][1] * f; }
            }
            const bf16x8 w0 = *(const bf16x8*)(Wb0 + k0), w1 = *(const bf16x8*)(Wb1 + k0);
#pragma unroll
            for (int m = 0; m < 4; ++m) {
                const bf16x8 a = *(const bf16x8*)(Ab + (size_t)m * 16 * lda + k0);
                acc[m][0] = __builtin_amdgcn_mfma_f32_16x16x32_bf16(w0, a, acc[m][0], 0, 0, 0);
                acc[m][1] = __builtin_amdgcn_mfma_f32_16x16x32_bf16(w1, a, acc[m][1], 0, 0, 0);
            }
        }
        float* tgt = e.ssq(pn);
#pragma unroll
        for (int m = 0; m < 4; ++m) {
            const int row = rt * 64 + m * 16 + fr;
            float s = e(row, ct * 32 + 8 * fq, acc[m][0], acc[m][1]);
            if (tgt) { s += __shfl_xor(s, 16); s += __shfl_xor(s, 32); if (fq == 0) atomicAdd(tgt + row, s); }
        }
    }
}

__global__ __launch_bounds__(256) void naive_attn(const bf16_t* __restrict__ Q, const bf16_t* __restrict__ K, const bf16_t* __restrict__ V, bf16_t* __restrict__ mix, float* __restrict__ ssq_a) {
    const int h = blockIdx.y, row = blockIdx.x * 256 + threadIdx.x;
    const int s0 = row < M_PROMPT ? (blockIdx.x * 256 / SEQ_P) * SEQ_P : M_PROMPT, len = row < M_PROMPT ? SEQ_P : SEQ_S;
    float q[DQK], o[DV];
#pragma unroll
    for (int d = 0; d < DQK; ++d) q[d] = bf2f(Q[(size_t)row * 768 + h * DQK + d]);
#pragma unroll
    for (int d = 0; d < DV; ++d) o[d] = 0.f;
    float m = -1e30f, l = 0.f;
    for (int j = 0; j < len; ++j) {
        const bf16_t* kp = K + (size_t)(s0 + j) * 768 + h * DQK; const bf16_t* vp = V + (size_t)(s0 + j) * 512 + h * DV;
        float s = 0.f;
#pragma unroll
        for (int d = 0; d < DQK; ++d) s += q[d] * bf2f(kp[d]);
        if (s > m) { const float a = exp2f(m - s); l *= a;
#pragma unroll
            for (int d = 0; d < DV; ++d) o[d] *= a;
            m = s; }
        const float p = exp2f(s - m); l += p;
#pragma unroll
        for (int d = 0; d < DV; ++d) o[d] += p * bf2f(vp[d]);
    }
    const float il = 1.f / l; float ss = 0.f;
#pragma unroll
    for (int d = 0; d < DV; ++d) { o[d] *= il; ss += o[d] * o[d]; }
#pragma unroll
    for (int d = 0; d < DV; d += 2) *(unsigned*)(mix + (size_t)row * 1024 + h * DV + d) = pk2(o[d], o[d + 1]);
    atomicAdd(ssq_a + row, ss);
}

__global__ __launch_bounds__(64) void naive_ssm(const bf16_t* __restrict__ ua, float* __restrict__ Y, int dir, const float* lam_re, const float* lam_im, const float* log_dt,
                                                const float* b_re, const float* b_im, const float* c_re, const float* c_im, const float* d_skip) {
    const int n = threadIdx.x, g = blockIdx.x & 31, sq = blockIdx.x >> 5;
    const int s0 = sq < 8 ? sq * SEQ_P : M_PROMPT, len = sq < 8 ? SEQ_P : SEQ_S;
    const int pi = (dir * NG + g) * NS + n;
    const float lr = lam_re[pi], li = lam_im[pi], dt = expf(log_dt[dir * NG + g]);
    const float mag = expf(lr * dt); float sn, cs; sincosf(li * dt, &sn, &cs);
    const float ar = mag * cs, ai = mag * sn;
    const float nr = ar - 1.f, ni = ai, den = lr * lr + li * li;
    const float fr_ = (nr * lr + ni * li) / den, fi_ = (ni * lr - nr * li) / den;
    float bbr[GH], bbi[GH], cr[GH], ci[GH];
#pragma unroll
    for (int h = 0; h < GH; ++h) {
        const float br = b_re[(size_t)pi * GH + h], bi = b_im[(size_t)pi * GH + h];
        bbr[h] = fr_ * br - fi_ * bi; bbi[h] = fr_ * bi + fi_ * br;
        cr[h] = c_re[((size_t)(dir * NG + g) * GH + h) * NS + n]; ci[h] = c_im[((size_t)(dir * NG + g) * GH + h) * NS + n];
    }
    const int hsel = ((n >> 5) & 1) * 8 + ((n >> 4) & 1) * 4 + ((n >> 3) & 1) * 2 + ((n >> 2) & 1);
    float xr = 0.f, xi = 0.f;
    const int nch = len / CT, c0 = s0 / CT;
    for (int cc = 0; cc < nch; ++cc) {
        const int chunk = c0 + (dir == 0 ? cc : nch - 1 - cc);
        const u32x2 raw = *(const u32x2*)(ua + ((size_t)chunk * 32 + g) * 512 + n * 4);
        float uv[4]; uv[0] = __builtin_bit_cast(float, raw.x << 16); uv[1] = __builtin_bit_cast(float, raw.x & 0xffff0000u);
        uv[2] = __builtin_bit_cast(float, raw.y << 16); uv[3] = __builtin_bit_cast(float, raw.y & 0xffff0000u);
#pragma unroll
        for (int tt = 0; tt < CT; ++tt) {
            const int t = dir == 0 ? tt : CT - 1 - tt;
            float u[GH];
#pragma unroll
            for (int h = 0; h < GH; ++h) u[h] = __shfl(uv[h & 3], t * 4 + (h >> 2));
            float bur = 0.f, bui = 0.f;
#pragma unroll
            for (int h = 0; h < GH; ++h) { bur += bbr[h] * u[h]; bui += bbi[h] * u[h]; }
            const float nxr = ar * xr - ai * xi + bur, nxi = ar * xi + ai * xr + bui; xr = nxr; xi = nxi;
            float v[GH];
#pragma unroll
            for (int h = 0; h < GH; ++h) v[h] = cr[h] * xr - ci[h] * xi;
#pragma unroll
            for (int i = 0; i < 8; ++i) { const bool up = n & 32; const float send = up ? v[i] : v[i + 8], keep = up ? v[i + 8] : v[i]; v[i] = keep + __shfl_xor(send, 32); }
#pragma unroll
            for (int i = 0; i < 4; ++i) { const bool up = n & 16; const float send = up ? v[i] : v[i + 4], keep = up ? v[i + 4] : v[i]; v[i] = keep + __shfl_xor(send, 16); }
#pragma unroll
            for (int i = 0; i < 2; ++i) { const bool up = n & 8; const float send = up ? v[i] : v[i + 2], keep = up ? v[i + 2] : v[i]; v[i] = keep + __shfl_xor(send, 8); }
            { const bool up = n & 4; const float send = up ? v[0] : v[1], keep = up ? v[1] : v[0]; v[0] = keep + __shfl_xor(send, 4); }
            v[0] += __shfl_xor(v[0], 2); v[0] += __shfl_xor(v[0], 1);
            if ((n & 3) == 0) {
                float* yp = Y + (size_t)(chunk * CT + t) * SSMW + g * GH + hsel;
                if (dir == 0) *yp = v[0]; else *yp += v[0];
            }
        }
    }
}
__global__ __launch_bounds__(256) void naive_ssm_finish(const float* __restrict__ Y, const bf16_t* __restrict__ ua, const float* __restrict__ d_skip, bf16_t* __restrict__ G) {
    const size_t i = (size_t)blockIdx.x * 256 + threadIdx.x;
    if (i < (size_t)M_TOK * SSMW) {
        const int row = (int)(i >> 9), col = (int)(i & 511), g = col >> 4, h = col & 15;
        const float u = bf2f(ua[((size_t)(row >> 4) * 32 + g) * 512 + (row & 15) * 16 + h]);
        G[i] = (bf16_t)f2bf(gelu_tanh(Y[i] + d_skip[col] * u));
    }
}

__device__ __forceinline__ void final_norm_rows(float* out, const float* ssq_x2, const float* fg, int gw, int ngw, int lane) {
    for (int m = gw; m < M_TOK; m += ngw) {
        const float r = rsqrtf(ssq_x2[m] * (1.f / DM) + EPS);
        f32x4* o = (f32x4*)(out + (size_t)m * DM) + lane;
#pragma unroll
        for (int j = 0; j < 4; ++j) { const f32x4 g = *((const f32x4*)fg + lane + 64 * j); o[64 * j] = o[64 * j] * r * g; }
    }
}
__global__ __launch_bounds__(256) void naive_final(float* out, const float* ssq_x2, const float* fg) {
    final_norm_rows(out, ssq_x2, fg, blockIdx.x * 4 + (threadIdx.x >> 6), gridDim.x * 4, threadIdx.x & 63);
}

constexpr int NWAVES = 8;
template <class MAP>
__device__ __forceinline__ void transpose_item(const float* W, int K, int N, bf16_t* WT, LAS float* scr, int item, int lane, int nblk, const MAP& map, const float* gain0, const float* gain1, int gsplit) {
    const int kb = item / nblk, nb = item % nblk, k0 = 64 * kb, n0 = 32 * nb;
    const int sc = map(n0 + (lane & 31));
#pragma unroll 8
    for (int i = 0; i < 32; ++i) {
        const int kk = 2 * i + (lane >> 5), k = k0 + kk;
        float v = sc >= 0 ? W[(size_t)k * N + sc] : 0.f;
        if (gain0) v *= (k < gsplit ? gain0[k] : gain1[k - gsplit]);
        scr[kk * 33 + (lane & 31)] = v;
    }
    asm volatile("s_waitcnt lgkmcnt(0)" ::: "memory");
    const int c = lane & 7;
#pragma unroll
    for (int j = 0; j < 4; ++j) {
        const int n = (lane >> 3) + 8 * j; const LAS float* s = scr + (8 * c) * 33 + n;
        u32x4 o; o.x = pk2(s[0 * 33], s[1 * 33]); o.y = pk2(s[2 * 33], s[3 * 33]); o.z = pk2(s[4 * 33], s[5 * 33]); o.w = pk2(s[6 * 33], s[7 * 33]);
        *(u32x4*)(WT + (size_t)(n0 + n) * K + k0 + 8 * c) = o;
    }
    asm volatile("s_waitcnt lgkmcnt(0)" ::: "memory");
}
struct MapId { __device__ __forceinline__ int operator()(int n) const { return n; } };
struct MapWin { __device__ __forceinline__ int operator()(int n) const { if (n < 384) return n; if (n < 416) return 384 + rope_logical(n - 384); if (n < 512) return -1; return 416 + (n - 512); } };
struct MapWuq { __device__ __forceinline__ int operator()(int n) const { const int h = n / DQK, d = n % DQK; return h * DQK + (d < DNOPE ? d : DNOPE + rope_logical(d - DNOPE)); } };

struct cpx { float r, i; };
__device__ __forceinline__ cpx cmul(cpx a, cpx b) { return {a.r * b.r - a.i * b.i, a.r * b.i + a.i * b.r}; }
__device__ __forceinline__ cpx apow(float lr, float li, float dt, float p) { const float mag = expf(lr * dt * p); float sn, cs; sincosf(li * dt * p, &sn, &cs); return {mag * cs, mag * sn}; }
__device__ __forceinline__ cpx bfac(float lr, float li, float dt) {
    const cpx a = apow(lr, li, dt, 1.f); const float nr = a.r - 1.f, ni = a.i, den = lr * lr + li * li;
    return {(nr * lr + ni * li) / den, (ni * lr - nr * li) / den};
}

__device__ __forceinline__ void prologue(const Params& p, LAS unsigned char* lds, int vcu, int G) {
    const int tid = threadIdx.x, lane = tid & 63, wave = tid >> 6;
    const int gw = vcu * NWAVES + wave, NGW = G * NWAVES;
    unsigned char* ws = p.ws;
    LAS float* scr = (LAS float*)(lds + wave * 16384);
    {
        constexpr int I_WIN = 16 * 32, I_WUQ = 4 * 24, I_WUKV = 2 * 32, I_WGLU = 8 * 16, I_WOUT = 16 * 32, I_W1 = 16 * 128, I_W2 = 64 * 32;
        constexpr int NITEMS = I_WIN + I_WUQ + I_WUKV + I_WGLU + I_WOUT + I_W1 + I_W2;
        for (int it = gw; it < NITEMS; it += NGW) {
            int r = it;
            if (r < I_WIN) { transpose_item(p.in[3], 1024, INW, (bf16_t*)(ws + WS_WIN), scr, r, lane, 32, MapWin(), p.in[2], p.in[2], 1 << 30); continue; } r -= I_WIN;
            if (r < I_WUQ) { transpose_item(p.in[5], 256, 768, (bf16_t*)(ws + WS_WUQ), scr, r, lane, 24, MapWuq(), p.in[4], p.in[4], 1 << 30); continue; } r -= I_WUQ;
            if (r < I_WUKV) { transpose_item(p.in[7], 128, 1024, (bf16_t*)(ws + WS_WUKV), scr, r, lane, 32, MapId(), p.in[6], p.in[6], 1 << 30); continue; } r -= I_WUKV;
            if (r < I_WGLU) { transpose_item(p.in[16], 512, 512, (bf16_t*)(ws + WS_WGLU), scr, r, lane, 16, MapId(), nullptr, nullptr, 0); continue; } r -= I_WGLU;
            if (r < I_WOUT) { transpose_item(p.in[20], 1024, 1024, (bf16_t*)(ws + WS_WOUT), scr, r, lane, 32, MapId(), p.in[18], p.in[19], 512); continue; } r -= I_WOUT;
            if (r < I_W1) { transpose_item(p.in[22], 1024, 4096, (bf16_t*)(ws + WS_W1), scr, r, lane, 128, MapId(), p.in[21], p.in[21], 1 << 30); continue; } r -= I_W1;
            transpose_item(p.in[23], 4096, 1024, (bf16_t*)(ws + WS_W2), scr, r, lane, 32, MapId(), nullptr, nullptr, 0);
        }
    }
    {
        float* stat = (float*)(ws + WS_STAT); bf16_t* xb = (bf16_t*)(ws + WS_XB);
        for (int m = gw; m < M_TOK; m += NGW) {
            const float* xrow = m < M_PROMPT ? p.in[0] + (size_t)m * DM : p.in[1] + (size_t)(m - M_PROMPT) * DM;
            const f32x4* xr = (const f32x4*)xrow + lane;
            f32x4 v[4]; float s = 0.f;
#pragma unroll
            for (int j = 0; j < 4; ++j) { v[j] = xr[64 * j]; s += (v[j].x * v[j].x + v[j].y * v[j].y) + (v[j].z * v[j].z + v[j].w * v[j].w); }
            s = wave_sum(s);
            unsigned long long* o8 = (unsigned long long*)(xb + (size_t)m * DM) + lane;
#pragma unroll
            for (int j = 0; j < 4; ++j) o8[64 * j] = (unsigned long long)pk2(v[j].x, v[j].y) | ((unsigned long long)pk2(v[j].z, v[j].w) << 32);
            if (lane == 0) stat[ST_RSTD1 * M_TOK + m] = rsqrtf(s * (1.f / DM) + EPS);
            else if (lane < 7) stat[lane * M_TOK + m] = 0.f;
        }
    }
    {
        float* cosT = (float*)(ws + WS_ROPE); float* sinT = cosT + SEQ_S * 16;
        for (int i = gw * 64 + lane; i < SEQ_S * 16; i += NGW * 64) {
            const int pos = i >> 4, j = i & 15;
            const float inv = powf(10000.f, -(float)(2 * j) / 32.f);
            const float ang = (float)pos * inv; float sn, cs; sincosf(ang, &sn, &cs);
            cosT[i] = cs; sinT[i] = sn;
        }
    }
    {
        const float* lam_re = p.in[8]; const float* lam_im = p.in[9]; const float* log_dt = p.in[10];
        const float* b_re = p.in[11]; const float* b_im = p.in[12]; const float* c_re = p.in[13]; const float* c_im = p.in[14]; const float* d_skip = p.in[15];
        bf16_t* MQ = (bf16_t*)(ws + WS_MQ); bf16_t* SP = (bf16_t*)(ws + WS_SP); float* AT = (float*)(ws + WS_AT);
        for (int it = gw; it < NG * CT * 2; it += NGW) {
            const int dir = it & 1, k = (it >> 1) & 15, g = it >> 5;
            if (k == 0 && dir == 1) continue;
            const int h = lane >> 2, hp0 = (lane & 3) * 4;
            float e[4] = {0.f, 0.f, 0.f, 0.f};
            const int ndir = (k == 0) ? 2 : 1;
            for (int dd = 0; dd < ndir; ++dd) {
                const int d = (k == 0) ? dd : dir;
                const int pi = (d * NG + g) * NS + lane;
                const float lr = lam_re[pi], li = lam_im[pi], dt = expf(log_dt[d * NG + g]);
                const cpx coef = cmul(apow(lr, li, dt, (float)k), bfac(lr, li, dt));
                for (int n = 0; n < NS; ++n) {
                    const cpx cf = {__shfl(coef.r, n), __shfl(coef.i, n)};
                    const size_t ci_ = ((size_t)(d * NG + g) * GH + h) * NS + n;
                    const cpx cc = cmul({c_re[ci_], c_im[ci_]}, cf);
                    const size_t bi_ = ((size_t)(d * NG + g) * NS + n) * GH + hp0;
#pragma unroll
                    for (int q = 0; q < 4; ++q) e[q] += cc.r * b_re[bi_ + q] - cc.i * b_im[bi_ + q];
                }
            }
            if (k == 0) {
#pragma unroll
                for (int q = 0; q < 4; ++q) if (hp0 + q == h) e[q] += d_skip[g * GH + h];
            }
            const unsigned long long w = (unsigned long long)pk2(e[0], e[1]) | ((unsigned long long)pk2(e[2], e[3]) << 32);
            for (int t = 0; t < CT; ++t) {
                const int j = (k == 0) ? t : (dir == 0 ? t - k : t + k);
                if (j < 0 || j >= CT) continue;
                *(unsigned long long*)(MQ + ((size_t)g * 256 + t * 16 + h) * 512 + j * 16 + hp0) = w;
            }
        }
        for (int i = gw * 64 + lane; i < NG * 256 * 256; i += NGW * 64) {
            const int s = i & 255, rr = (i >> 8) & 255, g = i >> 16;
            const int dir = s >> 7, part = (s >> 6) & 1, n = s & 63;
            const int pi = (dir * NG + g) * NS + n;
            const float lr = lam_re[pi], li = lam_im[pi], dt = expf(log_dt[dir * NG + g]);
            {
                const int t = rr >> 4, h = rr & 15;
                const cpx a = apow(lr, li, dt, (float)(dir == 0 ? t + 1 : CT - t));
                const size_t ci_ = ((size_t)(dir * NG + g) * GH + h) * NS + n;
                const cpx v = cmul({c_re[ci_], c_im[ci_]}, a);
                MQ[((size_t)g * 256 + rr) * 512 + 256 + s] = (bf16_t)f2bf(part == 0 ? v.r : -v.i);
            }
            {
                const int j = rr >> 4, hp = rr & 15;
                const cpx a = cmul(apow(lr, li, dt, (float)(dir == 0 ? CT - 1 - j : j)), bfac(lr, li, dt));
                const size_t bi_ = ((size_t)(dir * NG + g) * NS + n) * GH + hp;
                const cpx v = cmul(a, {b_re[bi_], b_im[bi_]});
                SP[((size_t)g * 256 + s) * 256 + rr] = (bf16_t)f2bf(part == 0 ? v.r : v.i);
            }
        }
        for (int i = gw * 64 + lane; i < 2 * NG * NS; i += NGW * 64) {
            const float lr = lam_re[i], li = lam_im[i], dt = expf(log_dt[i >> 6]);
            const cpx a = apow(lr, li, dt, (float)CT); AT[2 * i] = a.r; AT[2 * i + 1] = a.i;
        }
    }
}


namespace att {
using s16x4 = __attribute__((ext_vector_type(4))) short;
using f32x16 = __attribute__((ext_vector_type(16))) float;
constexpr int QBLK = 32, KVBLK = 64;
constexpr int SHM_V = KVBLK * DV * 2, SHM_K = KVBLK * 256;
constexpr int NSLOT = 3, OFF_V = 0, OFF_K = NSLOT * SHM_V, OFF_WS = NSLOT * (SHM_V + SHM_K);
constexpr float THRL = 8.f;
#define KSWZ(row, colB) ((row) * 256 + ((colB) ^ (((row) & 15) << 4)))
#define SBAR() __builtin_amdgcn_sched_barrier(0)
__device__ __forceinline__ int crow(int r, int hi) { return (r & 3) + 8 * (r >> 2) + 4 * hi; }
__device__ __forceinline__ unsigned cvtpk(float lo, float hi) { unsigned r; asm volatile("v_cvt_pk_bf16_f32 %0, %1, %2" : "=v"(r) : "v"(lo), "v"(hi)); return r; }
template <int ABL> __device__ __forceinline__ void partialSM(f32x16& p0, f32x16& p1, float& m_reg, float& alpha) {
    float pmax = p0[0];
#pragma unroll
    for (int r = 1; r < 16; ++r) pmax = fmaxf(pmax, p0[r]);
#pragma unroll
    for (int r = 0; r < 16; ++r) pmax = fmaxf(pmax, p1[r]);
    { auto rr = __builtin_amdgcn_permlane32_swap(__float_as_uint(pmax), __float_as_uint(pmax), false, false); pmax = fmaxf(__uint_as_float(rr[0]), __uint_as_float(rr[1])); }
    float mn;
    if (__builtin_expect(__all(pmax - m_reg <= THRL), 1)) { mn = m_reg; alpha = 1.f; }
    else { mn = fmaxf(m_reg, pmax); alpha = __builtin_amdgcn_exp2f(m_reg - mn); m_reg = mn; }
#pragma unroll
    for (int r = 0; r < 16; ++r) { p0[r] -= mn; p1[r] -= mn; }
    if (ABL != 3) {
#pragma unroll
    for (int r = 0; r < 16; ++r) p0[r] = __builtin_amdgcn_exp2f(p0[r]); }
}
template <int ABL> __device__ __forceinline__ void finishSM(f32x16& p0, f32x16& p1, float alpha, float& l_reg, bf16x8& pa0, bf16x8& pa1, bf16x8& pa2, bf16x8& pa3) {
    if (ABL != 3) {
#pragma unroll
    for (int r = 0; r < 16; ++r) p1[r] = __builtin_amdgcn_exp2f(p1[r]); }
    float ps = 0;
#pragma unroll
    for (int r = 0; r < 16; ++r) ps += p0[r];
#pragma unroll
    for (int r = 0; r < 16; ++r) ps += p1[r];
    { auto rr = __builtin_amdgcn_permlane32_swap(__float_as_uint(ps), __float_as_uint(ps), false, false); ps = __uint_as_float(rr[0]) + __uint_as_float(rr[1]); }
    l_reg = l_reg * alpha + ps;
#define PK4(P, BASE, OUT) do { unsigned a0 = cvtpk(P[BASE + 0], P[BASE + 1]), a1 = cvtpk(P[BASE + 2], P[BASE + 3]);   \
    unsigned b0 = cvtpk(P[BASE + 4], P[BASE + 5]), b1 = cvtpk(P[BASE + 6], P[BASE + 7]);                              \
    auto r0 = __builtin_amdgcn_permlane32_swap(a0, b0, false, false); auto r1 = __builtin_amdgcn_permlane32_swap(a1, b1, false, false); \
    u32x4 w = {r0[0], r1[0], r0[1], r1[1]}; OUT = __builtin_bit_cast(bf16x8, w); } while (0)
    PK4(p0, 0, pa0); PK4(p0, 8, pa1); PK4(p1, 0, pa2); PK4(p1, 8, pa3);
#undef PK4
}
template <int ABL> __device__ __forceinline__ void qkt(f32x16& p0, f32x16& p1, const LAS unsigned char* Ks, const bf16x8* qr, int r32, int hi) {
    p0 = f32x16{}; p1 = f32x16{};
    if (ABL == 4) { asm volatile("" : "+v"(p0), "+v"(p1)); return; }
#pragma unroll
    for (int d0 = 0; d0 < DQK / 16; ++d0) { const int cb = (d0 * 16 + hi * 8) * 2;
        bf16x8 b0, b1;
        if (ABL == 6) { b0 = qr[d0]; b1 = qr[(d0 + 1) % (DQK / 16)]; }
        else { b0 = *(const LAS bf16x8*)(Ks + KSWZ(r32, cb)); b1 = *(const LAS bf16x8*)(Ks + KSWZ(32 + r32, cb)); }
        p0 = __builtin_amdgcn_mfma_f32_32x32x16_bf16(b0, qr[d0], p0, 0, 0, 0);
        p1 = __builtin_amdgcn_mfma_f32_32x32x16_bf16(b1, qr[d0], p1, 0, 0, 0); }
}
__device__ __forceinline__ int v_st(int k, int c) { const int kk = (k & ~0xC) | ((k & 4) << 1) | ((k & 8) >> 1); return ((kk >> 3) * 2 + (c >> 5)) * 512 + ((kk & 7) * 32 + (c & 31)) * 2; }
__device__ __forceinline__ int v_rd_base(int lane) { return ((lane & 3) << 3) | (((lane >> 2) & 3) << 6) | (((lane >> 4) & 1) << 5) | (((lane >> 5) & 1) << 8); }
constexpr int v_rd_off(int d0, int ks, int half) { return d0 * 512 + ks * 2048 + half * 1024; }
template <int OFF> __device__ __forceinline__ s16x4 tr_read(int vb) { s16x4 r; asm volatile("ds_read_b64_tr_b16 %0, %1 offset:%2" : "=&v"(r) : "v"(vb), "i"(OFF) : "memory"); return r; }
template <int D0, int ABL> __device__ __forceinline__ void pv_one(f32x16& od, int vb, bf16x8 pa0, bf16x8 pa1, bf16x8 pa2, bf16x8 pa3) {
    if (ABL == 5) { asm volatile("" : "+v"(od) : "v"(pa0), "v"(pa1), "v"(pa2), "v"(pa3)); return; }
    if (ABL == 7) { od = __builtin_amdgcn_mfma_f32_32x32x16_bf16(pa0, pa1, od, 0, 0, 0); od = __builtin_amdgcn_mfma_f32_32x32x16_bf16(pa1, pa2, od, 0, 0, 0); od = __builtin_amdgcn_mfma_f32_32x32x16_bf16(pa2, pa3, od, 0, 0, 0); od = __builtin_amdgcn_mfma_f32_32x32x16_bf16(pa3, pa0, od, 0, 0, 0); return; }
    const s16x4 l0 = tr_read<v_rd_off(D0, 0, 0)>(vb), h0 = tr_read<v_rd_off(D0, 0, 1)>(vb), l1 = tr_read<v_rd_off(D0, 1, 0)>(vb), h1 = tr_read<v_rd_off(D0, 1, 1)>(vb);
    const s16x4 l2 = tr_read<v_rd_off(D0, 2, 0)>(vb), h2 = tr_read<v_rd_off(D0, 2, 1)>(vb), l3 = tr_read<v_rd_off(D0, 3, 0)>(vb), h3 = tr_read<v_rd_off(D0, 3, 1)>(vb);
    asm volatile("s_waitcnt lgkmcnt(0)" ::: "memory"); SBAR();
#define PK(L, H) (bf16x8){L[0], L[1], L[2], L[3], H[0], H[1], H[2], H[3]}
    od = __builtin_amdgcn_mfma_f32_32x32x16_bf16(pa0, PK(l0, h0), od, 0, 0, 0);
    od = __builtin_amdgcn_mfma_f32_32x32x16_bf16(pa1, PK(l1, h1), od, 0, 0, 0);
    od = __builtin_amdgcn_mfma_f32_32x32x16_bf16(pa2, PK(l2, h2), od, 0, 0, 0);
    od = __builtin_amdgcn_mfma_f32_32x32x16_bf16(pa3, PK(l3, h3), od, 0, 0, 0);
#undef PK
}
template <int ABL> __device__ __forceinline__ void attn_unit(const bf16_t* __restrict__ Q, const bf16_t* __restrict__ K, const bf16_t* __restrict__ V, bf16_t* __restrict__ MIX, float* __restrict__ ssq_a,
                                          int row0, int h, int s0, int seq, LAS unsigned char* lds) {
    int tid = threadIdx.x; asm volatile("" : "+v"(tid));
    const int wid = tid >> 6, lane = tid & 63, r32 = lane & 31, hi = lane >> 5;
    LAS unsigned char* V_lds = lds + OFF_V; LAS unsigned char* K_lds = lds + OFF_K;
    LAS float* wsf = (LAS float*)(lds + OFF_WS) + wid * 64; LAS float* li_l = wsf; LAS float* al_l = wsf + 32;
    float m_reg = -1e30f, l_reg = 0; f32x16 o[2] = {}; bf16x8 qr[DQK / 16];
    const bf16_t* Qw = Q + (size_t)(row0 + wid * QBLK + r32) * 768 + h * DQK + hi * 8;
#pragma unroll
    for (int d0 = 0; d0 < DQK / 16; ++d0) qr[d0] = *(const bf16x8*)(Qw + d0 * 16);
    const bf16_t* Kh = K + (size_t)s0 * 768 + h * DQK; const bf16_t* Vh = V + (size_t)s0 * 512 + h * DV;
    const int kr0 = tid / 12, kc0 = tid % 12, kr1 = (512 + tid) / 12, kc1 = (512 + tid) % 12, vr = tid >> 3, vc = tid & 7;
    const bool k2 = tid < 256;
    const int kst0 = KSWZ(kr0, kc0 * 16), kst1 = KSWZ(kr1, kc1 * 16), vst = v_st(vr, vc * 8);
    const bf16_t* kg0 = Kh + (size_t)kr0 * 768 + kc0 * 8; const bf16_t* kg1 = Kh + (size_t)kr1 * 768 + kc1 * 8; const bf16_t* vg = Vh + (size_t)vr * 512 + vc * 8;
    const int vb0 = (int)(unsigned)(uintptr_t)V_lds + v_rd_base(lane);
    struct { bf16x8 k0, k1, v; } sr_[2] = {};
#define ABSYNC() do { if (ABL != 1) __syncthreads(); } while (0)
#define SLOAD(i, kk0) do { if (ABL == 2) break; sr_[i].k0 = *(const bf16x8*)(kg0 + (size_t)(kk0) * 768); if (k2) sr_[i].k1 = *(const bf16x8*)(kg1 + (size_t)(kk0) * 768); sr_[i].v = *(const bf16x8*)(vg + (size_t)(kk0) * 512); } while (0)
#define SWRITE(b, i) do { if (ABL == 2) break; *(LAS bf16x8*)(V_lds + (b) * SHM_V + vst) = sr_[i].v; *(LAS bf16x8*)(K_lds + (b) * SHM_K + kst0) = sr_[i].k0; if (k2) *(LAS bf16x8*)(K_lds + (b) * SHM_K + kst1) = sr_[i].k1; } while (0)
#define RESC(a) do { if (__any((a) < 1.f)) { if (hi == 0) al_l[r32] = (a); asm volatile("s_waitcnt lgkmcnt(0)" ::: "memory"); \
    _Pragma("unroll") for (int d = 0; d < 2; ++d) _Pragma("unroll") for (int r = 0; r < 16; ++r) o[d][r] *= al_l[crow(r, hi)]; } } while (0)
    f32x16 pA0, pA1, pB0, pB1; float alA, alB; bf16x8 pa0, pa1, pa2, pa3; const int NT = seq / KVBLK;
    int sp = 0, sc = 0, sn = 1;
#define ROT() do { sp = sc; sc = sn; sn = (sn == NSLOT - 1) ? 0 : sn + 1; } while (0)
    SLOAD(0, 0); SWRITE(0, 0); SLOAD(1, KVBLK); SLOAD(0, 2 * KVBLK); ABSYNC();
    qkt<ABL>(pA0, pA1, K_lds, qr, r32, hi); partialSM<ABL>(pA0, pA1, m_reg, alA);
    SWRITE(1, 1); SLOAD(1, 3 * KVBLK); ABSYNC();
    ROT();
    for (int j = 1; j + 1 < NT; j += 2) {
        SBAR(); qkt<ABL>(pB0, pB1, K_lds + sc * SHM_K, qr, r32, hi);
        finishSM<ABL>(pA0, pA1, alA, l_reg, pa0, pa1, pa2, pa3); SBAR();
        SWRITE(sn, 0); if (j + 3 < NT) SLOAD(0, (j + 3) * KVBLK); SBAR();
        pv_one<0, ABL>(o[0], vb0 + sp * SHM_V, pa0, pa1, pa2, pa3); pv_one<1, ABL>(o[1], vb0 + sp * SHM_V, pa0, pa1, pa2, pa3); partialSM<ABL>(pB0, pB1, m_reg, alB);
        RESC(alB); ABSYNC(); ROT();
        SBAR(); qkt<ABL>(pA0, pA1, K_lds + sc * SHM_K, qr, r32, hi);
        finishSM<ABL>(pB0, pB1, alB, l_reg, pa0, pa1, pa2, pa3); SBAR();
        if (j + 2 < NT) { SWRITE(sn, 1); if (j + 4 < NT) SLOAD(1, (j + 4) * KVBLK); } SBAR();
        pv_one<0, ABL>(o[0], vb0 + sp * SHM_V, pa0, pa1, pa2, pa3); pv_one<1, ABL>(o[1], vb0 + sp * SHM_V, pa0, pa1, pa2, pa3); partialSM<ABL>(pA0, pA1, m_reg, alA);
        RESC(alA); ABSYNC(); ROT();
    }
    SBAR(); qkt<ABL>(pB0, pB1, K_lds + sc * SHM_K, qr, r32, hi);
    finishSM<ABL>(pA0, pA1, alA, l_reg, pa0, pa1, pa2, pa3); SBAR();
    pv_one<0, ABL>(o[0], vb0 + sp * SHM_V, pa0, pa1, pa2, pa3); pv_one<1, ABL>(o[1], vb0 + sp * SHM_V, pa0, pa1, pa2, pa3); partialSM<ABL>(pB0, pB1, m_reg, alB);
    RESC(alB);
    finishSM<ABL>(pB0, pB1, alB, l_reg, pa0, pa1, pa2, pa3); SBAR();
    pv_one<0, ABL>(o[0], vb0 + sc * SHM_V, pa0, pa1, pa2, pa3); pv_one<1, ABL>(o[1], vb0 + sc * SHM_V, pa0, pa1, pa2, pa3);
#undef ROT
    if (hi == 0) li_l[r32] = l_reg; asm volatile("s_waitcnt lgkmcnt(0)" ::: "memory");
    bf16_t* Ow = MIX + (size_t)(row0 + wid * QBLK) * 1024 + h * DV;
#pragma unroll
    for (int r = 0; r < 16; ++r) { const int orow = crow(r, hi); const float rl = __builtin_amdgcn_rcpf(li_l[orow]);
        const float a = o[0][r] * rl, b = o[1][r] * rl;
        Ow[(size_t)orow * 1024 + r32] = (bf16_t)f2bf(a); Ow[(size_t)orow * 1024 + 32 + r32] = (bf16_t)f2bf(b);
        float ss = a * a + b * b;
        ss += __shfl_xor(ss, 1); ss += __shfl_xor(ss, 2); ss += __shfl_xor(ss, 4); ss += __shfl_xor(ss, 8); ss += __shfl_xor(ss, 16);
        if (r32 == 0) atomicAdd(ssq_a + row0 + wid * QBLK + orow, ss); }
    ABSYNC();
#undef SLOAD
#undef ABSYNC
#undef SWRITE
#undef RESC
}
template <int ABL> __device__ __forceinline__ void attn_phase(const bf16_t* Q, const bf16_t* K, const bf16_t* V, bf16_t* MIX, float* ssq_a, int vcu, int G, LAS unsigned char* lds) {
    constexpr int NU = 512 + 1024;
    const int nmine = (G == 256) ? 6 : (NU - vcu + G - 1) / G;
#pragma unroll 1
    for (int i = 0; i < nmine; ++i) {
        int u;
        if (G == 256) { const int x = vcu >> 5, l = vcu & 31; u = (i < 2) ? x * 64 + l + 32 * i : 512 + (8 * x) * 16 + (i - 2) * 32 + l; }
        else u = vcu + i * G;
        int row0, h, s0, seq;
        if (u < 512) { row0 = M_PROMPT + (u & 63) * 256; h = u >> 6; s0 = M_PROMPT; seq = SEQ_S; }
        else { const int pu = u - 512, bh = pu >> 4, qb = pu & 15, b = bh >> 3; h = bh & 7; s0 = b * SEQ_P; row0 = s0 + qb * 256; seq = SEQ_P; }
        attn_unit<ABL>(Q, K, V, MIX, ssq_a, row0, h, s0, seq, lds);
    }
}
#undef KSWZ
#undef SBAR
}

__device__ __forceinline__ void ssm_scan1(const float* __restrict__ LST, bf16_t* __restrict__ UA, const float* __restrict__ AT, float* __restrict__ ESEG, int vb, int tid) {
    const int r = vb * (NWAVES * 64) + tid;
    if (r >= 12 * 4096) return;
    const int item = r >> 12, rem = r & 4095, dir = rem >> 11, g = (rem >> 6) & 31, n = rem & 63;
    const int c0 = item * 256;
    const float ar = AT[2 * ((dir * NG + g) * NS + n)], ai = AT[2 * ((dir * NG + g) * NS + n) + 1];
    const size_t off = (size_t)g * 256 + dir * 128 + n;
    const int step = dir == 0 ? 1 : -1; const int c = dir == 0 ? c0 : c0 + 255;
    float xr = 0.f, xi = 0.f;
    const float* lp = LST + (size_t)c * 8192 + off;
    bf16_t* up = UA + (size_t)c * 16384 + g * 512 + 256 + dir * 128 + n;
#pragma unroll 1
    for (int b = 0; b < 256; b += 64) {
        int st = step; asm volatile("" : "+v"(st));
        const long ls = (long)st * 8192, us = (long)st * 16384;
        float lr[64], li[64];
#pragma unroll
        for (int k = 0; k < 64; ++k) { lr[k] = lp[0]; li[k] = lp[64]; lp += ls; }
#pragma unroll
        for (int k = 0; k < 64; ++k) {
            up[0] = (bf16_t)f2bf(xr); up[64] = (bf16_t)f2bf(xi); up += us;
            const float tr = ar * xr - ai * xi + lr[k], ti = ar * xi + ai * xr + li[k]; xr = tr; xi = ti;
        }
    }
    if (item >= 8) { float* e = ESEG + ((size_t)(item - 8) * 4096 + rem) * 2; e[0] = xr; e[1] = xi; }
}
__device__ __forceinline__ void ssm_scan2(bf16_t* __restrict__ UA, const float* __restrict__ ESEG, const float* lam_re, const float* lam_im, const float* log_dt, int gtid, int nthr) {
    for (int i = gtid; i < 768 * 4096; i += nthr) {
        const int rem = i & 4095, cc = i >> 12, dir = rem >> 11, g = (rem >> 6) & 31, n = rem & 63;
        const int q = cc >> 8, j = cc & 255, k = dir == 0 ? q + 1 : q;
        const int pi = (dir * NG + g) * NS + n;
        const float lr = lam_re[pi], li = lam_im[pi], dt = expf(log_dt[dir * NG + g]);
        const cpx A = apow(lr, li, dt, (float)(CT * 256));
        cpx carry = {0.f, 0.f};
        if (dir == 0) { for (int kk = 0; kk < k; ++kk) { const float* e = ESEG + ((size_t)kk * 4096 + rem) * 2; const cpx t = cmul(A, carry); carry = {t.r + e[0], t.i + e[1]}; } }
        else { for (int kk = 3; kk > k; --kk) { const float* e = ESEG + ((size_t)kk * 4096 + rem) * 2; const cpx t = cmul(A, carry); carry = {t.r + e[0], t.i + e[1]}; } }
        const cpx f = cmul(apow(lr, li, dt, (float)(CT * (dir == 0 ? j : 255 - j))), carry);
        bf16_t* up = UA + (size_t)(2048 + k * 256 + j) * 16384 + g * 512 + 256 + dir * 128 + n;
        up[0] = (bf16_t)f2bf(bf2f(up[0]) + f.r); up[64] = (bf16_t)f2bf(bf2f(up[64]) + f.i);
    }
}

#define XB_TMO      128
#define XB_XCNT(j)  (256  + 64 * (j))
#define XB_XSUB(j)  (1280 + 64 * (j))
#define XB_XGEN(j)  (2304 + 64 * (j))
#define XB_TOP      3328
#define XB_TOPGEN   3392
#define XCD_BAR_WORDS 3456
#define XB_SPIN_CAP (1u << 22)
__device__ __forceinline__ unsigned xb_ld(unsigned* p)              { return __hip_atomic_load(p, __ATOMIC_RELAXED, __HIP_MEMORY_SCOPE_AGENT); }
__device__ __forceinline__ unsigned xb_add(unsigned* p, unsigned v) { return __hip_atomic_fetch_add(p, v, __ATOMIC_RELAXED, __HIP_MEMORY_SCOPE_AGENT); }
__device__ __forceinline__ unsigned xb_xcc_id() { return (unsigned)__builtin_amdgcn_s_getreg((3 << 11) | 20) & 0xFu; }
#define XB_SPIN(cond, bar) do { unsigned _sp = 0; while (cond) { __builtin_amdgcn_s_sleep(1); \
    if ((++_sp & 255u) == 0u) { if (xb_ld(&(bar)[XB_TMO])) break; if (_sp > XB_SPIN_CAP) { atomicAdd(&(bar)[XB_TMO], 1u); break; } } } } while (0)
struct XcdBarrier { unsigned* bar; unsigned x; volatile LAS unsigned* st; };
__device__ __forceinline__ XcdBarrier xcd_barrier_post(unsigned* bar, volatile LAS unsigned* st) {
    XcdBarrier b; b.bar = bar; b.x = xb_xcc_id(); b.st = st;
    if (threadIdx.x == 0) (void)xb_add(&bar[XB_XCNT(b.x)], 1u);
    return b;
}
__device__ __forceinline__ void xcd_barrier_complete(unsigned* bar, unsigned x, unsigned& nloc, unsigned& nx) {
    const unsigned G = gridDim.x * gridDim.y * gridDim.z;
    unsigned sum, cnt, mine, sp = 0u;
    for (;;) {
        sum = 0u; cnt = 0u; mine = 0u;
#pragma unroll
        for (unsigned j = 0; j < 16; ++j) { const unsigned c = xb_ld(&bar[XB_XCNT(j)]); sum += c; cnt += (c > 0u) ? 1u : 0u; mine = (j == x) ? c : mine; }
        if (sum == G) break;
        __builtin_amdgcn_s_sleep(1);
        if ((++sp & 255u) == 0u) { if (xb_ld(&bar[XB_TMO])) break; if (sp > XB_SPIN_CAP) { atomicAdd(&bar[XB_TMO], 1u); break; } }
    }
    nloc = mine > 0u ? mine : 1u; nx = cnt > 0u ? cnt : 1u;
}
__device__ __forceinline__ void xcd_barrier(const XcdBarrier& b) {
    asm volatile("s_waitcnt vmcnt(0)" ::: "memory");
    __syncthreads();
    if (threadIdx.x == 0) {
        unsigned* bar = b.bar;
        __builtin_amdgcn_s_waitcnt(0);
        unsigned nloc = b.st[0], nx = b.st[1];
        if (nloc == 0u) { xcd_barrier_complete(bar, b.x, nloc, nx); b.st[0] = nloc; b.st[1] = nx; }
        const unsigned old = xb_add(&bar[XB_XSUB(b.x)], 1u);
        const unsigned gen = old / nloc;
        if (old + 1u == (gen + 1u) * nloc) {
            __builtin_amdgcn_fence(__ATOMIC_RELEASE, "agent");
            asm volatile("s_waitcnt vmcnt(0)" ::: "memory");
            const unsigned og = xb_add(&bar[XB_TOP], 1u);
            const unsigned tg = og / nx;
            if (og + 1u == (tg + 1u) * nx) xb_add(&bar[XB_TOPGEN], 1u);
            else XB_SPIN(xb_ld(&bar[XB_TOPGEN]) == tg, bar);
            __builtin_amdgcn_fence(__ATOMIC_ACQUIRE, "agent");
            xb_add(&bar[XB_XGEN(b.x)], 1u);
            asm volatile("s_waitcnt vmcnt(0)" ::: "memory");
        } else {
            XB_SPIN(xb_ld(&bar[XB_XGEN(b.x)]) == gen, bar);
            __builtin_amdgcn_fence(__ATOMIC_ACQUIRE, "agent");
            asm volatile("s_waitcnt vmcnt(0)" ::: "memory");
        }
    }
    __syncthreads();
}

constexpr int LDS_BYTES = 147456, MISC_OFF = 131072 + 320;
constexpr int N_PHASES = 15;
constexpr int PROBE_ABL = 0;
constexpr unsigned PROBE_MASK = 0u;
constexpr int CW_BAR = 4096;
__global__ void __launch_bounds__(NWAVES * 64, 2) mega(Params p) {
    extern __shared__ __attribute__((aligned(16))) unsigned char lds_raw[];
    LAS unsigned char* lds = (LAS unsigned char*)lds_raw;
    const int G = gridDim.x, bx = blockIdx.x, tid = threadIdx.x;
    const int vcu = (G % 8 == 0) ? (bx % 8) * (G / 8) + bx / 8 : bx;
    unsigned char* ws = p.ws;
    volatile LAS unsigned* MISC = (volatile LAS unsigned*)(lds + MISC_OFF);
    for (int u = tid; u < (LDS_BYTES - 131072) / 4; u += NWAVES * 64) ((LAS unsigned*)(lds + 131072))[u] = 0u;
    __syncthreads();
    const int lo = p.ph_lo, hi = p.ph_hi;
    XcdBarrier bar; bar.bar = (unsigned*)(ws + WS_CTL) + CW_BAR; bar.x = 0; bar.st = nullptr;
    if (hi - lo > 1) bar = xcd_barrier_post((unsigned*)(ws + WS_CTL) + CW_BAR, MISC + 8);
#ifndef PH_MASK
#define PH_MASK 0xFFFFu
#endif
#define IN(k) (((PH_MASK >> (k)) & 1u) && lo <= (k) && (k) < hi)
#define SEAM(k) do { if (IN(k) && IN((k) + 1)) xcd_barrier(bar); } while (0)
    float* stat = (float*)(ws + WS_STAT);
    const float* cosT = (const float*)(ws + WS_ROPE); const float* sinT = cosT + SEQ_S * 16;
    bf16_t* PROJ = (bf16_t*)(ws + WS_PROJ); bf16_t* GB = (bf16_t*)(ws + WS_PROJ); bf16_t* UA = (bf16_t*)(ws + WS_UA); bf16_t* X1B = (bf16_t*)(ws + WS_UA);
    bf16_t* XB = (bf16_t*)(ws + WS_XB); float* LST = (float*)(ws + WS_XB); bf16_t* HB = (bf16_t*)(ws + WS_XB); bf16_t* MIX = (bf16_t*)(ws + WS_MIX);
    bf16_t* Qb = (bf16_t*)p.out; bf16_t* Kb = Qb + (size_t)M_TOK * 768; bf16_t* Vb = Kb + (size_t)M_TOK * 768;

#define REPS(k) for (int rep = ((PROBE_MASK >> (k)) & 1u) ? 0 : 1; rep < 2; ++rep)
#define DRYBAR() do { if (rep == 0) xcd_barrier(bar); } while (0)
#define SQ(st_) (rep == 0 ? stat + 7 * M_TOK : stat + (st_) * M_TOK)
    if (IN(0)) REPS(0) { prologue(p, lds, vcu, G); DRYBAR(); } SEAM(0);
    if (IN(1)) REPS(1) { EpiProj e{stat + ST_RSTD1 * M_TOK, PROJ, UA, cosT, sinT, SQ(ST_SSQ), SQ(ST_SSKV)};
        pg8::run_gemm(lds, XB, 1024, 0, (const bf16_t*)(ws + WS_WIN), 1024, M_TOK, 1024, 1024, e, G, bx); DRYBAR(); } SEAM(1);
    if (IN(2)) REPS(2) {
        { EpiQ e{stat + ST_SSQ * M_TOK, Qb, cosT, sinT}; pg8::run_gemm(lds, PROJ, 512, 0, (const bf16_t*)(ws + WS_WUQ), 256, M_TOK, 768, 256, e, G, bx); }
        { EpiKV e{stat + ST_SSKV * M_TOK, PROJ, Kb, Vb}; pg8::run_gemm(lds, PROJ + 256, 512, 0, (const bf16_t*)(ws + WS_WUKV), 128, M_TOK, 1024, 128, e, G, bx); }
        { EpiLst e{LST}; pg8::run_gemm(lds, UA, 16384, 512, (const bf16_t*)(ws + WS_SP), 256, NCHUNK, 8192, 256, e, G, bx); }
        DRYBAR(); } SEAM(2);
    if (IN(3)) REPS(3) { ssm_scan1(LST, UA, (const float*)(ws + WS_AT), (float*)(ws + WS_ESEG), vcu, tid); DRYBAR(); } SEAM(3);
    if (IN(4)) REPS(4) { if (rep == 1) ssm_scan2(UA, (const float*)(ws + WS_ESEG), p.in[8], p.in[9], p.in[10], vcu * (NWAVES * 64) + tid, G * NWAVES * 64);
        if ((PROBE_MASK & 16u) && PROBE_ABL != 0 && rep == 0) att::attn_phase<PROBE_ABL>(Qb, Kb, Vb, MIX, SQ(ST_SSA), vcu, G, lds);
        else att::attn_phase<0>(Qb, Kb, Vb, MIX, SQ(ST_SSA), vcu, G, lds);
        DRYBAR(); } SEAM(4);
    if (IN(5)) REPS(5) { EpiSsmOut e{GB}; pg8::run_gemm(lds, UA, 16384, 512, (const bf16_t*)(ws + WS_MQ), 512, NCHUNK, 8192, 512, e, G, bx); DRYBAR(); } SEAM(5);
    if (IN(6)) REPS(6) { EpiGlu e{GB, p.in[17], MIX, SQ(ST_SSS)}; pg8::run_gemm(lds, GB, 512, 0, (const bf16_t*)(ws + WS_WGLU), 512, M_TOK, 512, 512, e, G, bx); DRYBAR(); } SEAM(6);
    if (IN(7)) REPS(7) { EpiOut e{p.in[0], p.in[1], stat + ST_SSS * M_TOK, p.out, X1B, SQ(ST_SSX1)};
        pg8::run_gemm(lds, MIX, 1024, 0, (const bf16_t*)(ws + WS_WOUT), 1024, M_TOK, 1024, 1024, e, G, bx, 8, stat + ST_SSA * M_TOK, stat + ST_SSS * M_TOK); DRYBAR(); } SEAM(7);
#pragma unroll 1
    for (int th = 0; th < 3; ++th) {
        const int r0 = th * 16384;
        if (IN(8 + 2 * th)) REPS(8) { EpiMlp1 e{stat + ST_SSX1 * M_TOK, HB, r0, 0};
            pg8::run_gemm(lds, X1B + (size_t)r0 * DM, 1024, 0, (const bf16_t*)(ws + WS_W1), 1024, 16384, 4096, 1024, e, G, bx); DRYBAR(); } SEAM(8 + 2 * th);
        if (IN(9 + 2 * th)) REPS(9) { EpiMlp2 e{p.out + (size_t)r0 * DM, rep == 0 ? (float*)(ws + WS_END) : p.out + (size_t)r0 * DM, (rep == 0 ? stat + 7 * M_TOK : stat + ST_SSX2 * M_TOK) + r0, r0, 0};
            pg8::run_gemm(lds, HB, 4096, 0, (const bf16_t*)(ws + WS_W2), 4096, 16384, 1024, 4096, e, G, bx); DRYBAR(); } SEAM(9 + 2 * th);
    }
    if (IN(14)) final_norm_rows(p.out, stat + ST_SSX2 * M_TOK, p.in[24], vcu * NWAVES + (tid >> 6), G * NWAVES, tid & 63);
#undef REPS
#undef DRYBAR
#undef SQ
#undef IN
#undef SEAM
}

extern "C" void kernel_launch(void* const* d_in, const int* in_sizes, int n_in, void* d_out, int out_size, void* d_ws, size_t ws_size, hipStream_t stream) {
    static int ok = 0;
    if (ok == 0) {
        if (n_in != 25 || out_size != M_TOK * DM || ws_size < WS_END + 64 * MiB) { fprintf(stderr, "kernel_launch: unexpected shapes n_in %d out %d ws %zu\n", n_in, out_size, ws_size); ok = -1; return; }
        if (hipFuncSetAttribute((const void*)mega, hipFuncAttributeMaxDynamicSharedMemorySize, LDS_BYTES) != hipSuccess) { fprintf(stderr, "kernel_launch: LDS attribute failed\n"); ok = -1; return; }
        ok = 1;
    }
    if (ok < 0) return;
    Params p{};
    for (int i = 0; i < 25; ++i) p.in[i] = (const float*)d_in[i];
    p.out = (float*)d_out; p.ws = (unsigned char*)d_ws;
    unsigned char* ws = (unsigned char*)d_ws;
    float* stat = (float*)(ws + WS_STAT);
    const float* cosT = (const float*)(ws + WS_ROPE); const float* sinT = cosT + SEQ_S * 16;
    bf16_t* PROJ = (bf16_t*)(ws + WS_PROJ); bf16_t* GB = (bf16_t*)(ws + WS_PROJ); bf16_t* UA = (bf16_t*)(ws + WS_UA); bf16_t* X1B = (bf16_t*)(ws + WS_UA);
    bf16_t* XB = (bf16_t*)(ws + WS_XB); float* YB = (float*)(ws + WS_XB); bf16_t* HB = (bf16_t*)(ws + WS_XB); bf16_t* MIX = (bf16_t*)(ws + WS_MIX);
    bf16_t* Qb = (bf16_t*)d_out; bf16_t* Kb = Qb + (size_t)M_TOK * 768; bf16_t* Vb = Kb + (size_t)M_TOK * 768;
    (void)hipMemsetAsync(ws + WS_CTL, 0, 1 * MiB, stream);
#define MEGA(a, b) do { p.ph_lo = (a); p.ph_hi = (b); hipLaunchKernelGGL(mega, dim3(256), dim3(512), LDS_BYTES, stream, p); } while (0)
    MEGA(0, N_PHASES);
#undef MEGA
}
```

```cpp
#include <hip/hip_runtime.h>
#include <cstdint>
#include <cstdio>

typedef unsigned short bf16_t;
typedef short bf16x8 __attribute__((ext_vector_type(8)));
typedef float f32x4 __attribute__((ext_vector_type(4)));
typedef float f32x2 __attribute__((ext_vector_type(2)));
typedef unsigned u32x4 __attribute__((ext_vector_type(4)));
typedef unsigned u32x2 __attribute__((ext_vector_type(2)));
#define LAS __attribute__((address_space(3)))

constexpr int DM = 1024, M_TOK = 49152, M_PROMPT = 32768, SEQ_P = 4096, SEQ_S = 16384;
constexpr int NH = 8, DQK = 96, DNOPE = 64, DROPE = 32, DV = 64, QR = 256, KVR = 128;
constexpr int SSMW = 512, NG = 32, GH = 16, NS = 64, DFF = 4096, INW = 928;
constexpr int CT = 16, NCHUNK = M_TOK / CT;
constexpr float EPS = 1e-6f;
constexpr float QSCALE = 0.10206207261596575f * 1.4426950408889634f;

constexpr size_t MiB = 1u << 20;
constexpr size_t WS_CTL = 0;
constexpr size_t WS_WIN = 1 * MiB;
constexpr size_t WS_WUQ = 3 * MiB;
constexpr size_t WS_WUKV = 3 * MiB + 384 * 1024;
constexpr size_t WS_WGLU = 4 * MiB;
constexpr size_t WS_WOUT = 5 * MiB;
constexpr size_t WS_W1 = 7 * MiB;
constexpr size_t WS_W2 = 15 * MiB;
constexpr size_t WS_MQ = 23 * MiB;
constexpr size_t WS_SP = 31 * MiB;
constexpr size_t WS_ROPE = 35 * MiB;
constexpr size_t WS_STAT = 37 * MiB;
constexpr size_t WS_AT = 39 * MiB;
constexpr size_t WS_ESEG = 39 * MiB + 64 * 1024;
constexpr size_t WS_PROJ = 40 * MiB;
constexpr size_t WS_UA = 88 * MiB;
constexpr size_t WS_XB = 184 * MiB;
constexpr size_t WS_MIX = 312 * MiB;
constexpr size_t WS_END = 408 * MiB;
enum { ST_RSTD1 = 0, ST_SSQ = 1, ST_SSKV = 2, ST_SSA = 3, ST_SSS = 4, ST_SSX1 = 5, ST_SSX2 = 6 };

struct Params {
    const float* in[25];
    float* out;
    unsigned char* ws;
    int ph_lo, ph_hi;
};

__device__ __forceinline__ unsigned f2bf(float f) { unsigned u = __builtin_bit_cast(unsigned, f); return (u + 0x7fffu + ((u >> 16) & 1u)) >> 16; }
__device__ __forceinline__ unsigned pk2(float lo, float hi) { return f2bf(lo) | (f2bf(hi) << 16); }
__device__ __forceinline__ float bf2f(unsigned short b) { return __builtin_bit_cast(float, (unsigned)b << 16); }
__device__ __forceinline__ void store8bf(bf16_t* p, f32x4 a, f32x4 b) {
    u32x4 w; w.x = pk2(a[0], a[1]); w.y = pk2(a[2], a[3]); w.z = pk2(b[0], b[1]); w.w = pk2(b[2], b[3]); *(u32x4*)p = w;
}
__device__ __forceinline__ void load8bf(const bf16_t* p, f32x4& a, f32x4& b) {
    const u32x4 w = *(const u32x4*)p;
    a[0] = __builtin_bit_cast(float, w.x << 16); a[1] = __builtin_bit_cast(float, w.x & 0xffff0000u);
    a[2] = __builtin_bit_cast(float, w.y << 16); a[3] = __builtin_bit_cast(float, w.y & 0xffff0000u);
    b[0] = __builtin_bit_cast(float, w.z << 16); b[1] = __builtin_bit_cast(float, w.z & 0xffff0000u);
    b[2] = __builtin_bit_cast(float, w.w << 16); b[3] = __builtin_bit_cast(float, w.w & 0xffff0000u);
}
__device__ __forceinline__ float sumsq8(f32x4 a, f32x4 b) { return (a[0] * a[0] + a[1] * a[1]) + (a[2] * a[2] + a[3] * a[3]) + (b[0] * b[0] + b[1] * b[1]) + (b[2] * b[2] + b[3] * b[3]); }
__device__ __forceinline__ int rope_logical(int p) { const int i = p & 7, gq = p >> 3; return i < 4 ? 4 * gq + i : 16 + 4 * gq + (i - 4); }
__device__ __forceinline__ int tok_pos(int row) { return row < M_PROMPT ? (row & (SEQ_P - 1)) : row - M_PROMPT; }
__device__ __forceinline__ int perm32(int rho) { const int n = rho >> 4, i = rho & 15; return 8 * (i >> 2) + 4 * n + (i & 3); }
__device__ __forceinline__ float wave_sum(float v) {
#pragma unroll
    for (int o = 1; o < 64; o <<= 1) v += __shfl_xor(v, o);
    return v;
}
__device__ __forceinline__ float gelu_tanh(float x) {
    const float z = 0.7978845608028654f * (x + 0.044715f * x * x * x);
    const float e = __expf(2.f * z);
    const float th = 1.f - 2.f / (1.f + e);
    return 0.5f * x * (1.f + th);
}

struct EpiProj {
    const float* rstd1; bf16_t* proj; bf16_t* ua; const float* cosT; const float* sinT; float* ssq_q; float* ssq_kv;
    __device__ __forceinline__ float* ssq(int pn) const { return pn == 0 ? ssq_q : (pn == 1 ? ssq_kv : nullptr); }
    __device__ __forceinline__ float operator()(int row, int col, f32x4 v0, f32x4 v1) const {
        const float r = rstd1[row]; v0 = v0 * r; v1 = v1 * r;
        if (col < 384) { store8bf(proj + (size_t)row * 512 + col, v0, v1); return sumsq8(v0, v1); }
        if (col < 416) {
            const int pos = tok_pos(row), gq = (col - 384) >> 3;
            const f32x4 c = *(const f32x4*)(cosT + pos * 16 + gq * 4), s = *(const f32x4*)(sinT + pos * 16 + gq * 4);
            const f32x4 o1 = v0 * c - v1 * s, o2 = v1 * c + v0 * s;
            store8bf(proj + (size_t)row * 512 + col, o1, o2); return 0.f;
        }
        if (col < 512) return 0.f;
        const int c2 = col - 512, g = c2 >> 4, h0 = c2 & 15, chunk = row >> 4, t = row & 15;
        store8bf(ua + ((size_t)chunk * 32 + g) * 512 + t * 16 + h0, v0, v1); return 0.f;
    }
};
struct EpiQ {
    const float* ssq_q; bf16_t* q; const float* cosT; const float* sinT;
    __device__ __forceinline__ float* ssq(int) const { return nullptr; }
    __device__ __forceinline__ float operator()(int row, int col, f32x4 v0, f32x4 v1) const {
        const float r = rsqrtf(ssq_q[row] * (1.f / QR) + EPS); v0 = v0 * r; v1 = v1 * r;
        const int d = col % DQK;
        if (d >= DNOPE) {
            const int pos = tok_pos(row), gq = (d - DNOPE) >> 3;
            const f32x4 c = *(const f32x4*)(cosT + pos * 16 + gq * 4), s = *(const f32x4*)(sinT + pos * 16 + gq * 4);
            const f32x4 o1 = v0 * c - v1 * s, o2 = v1 * c + v0 * s; v0 = o1; v1 = o2;
        }
        store8bf(q + (size_t)row * 768 + col, v0 * QSCALE, v1 * QSCALE); return 0.f;
    }
};
struct EpiKV {
    const float* ssq_kv; const bf16_t* proj; bf16_t* k; bf16_t* v;
    __device__ __forceinline__ float* ssq(int) const { return nullptr; }
    __device__ __forceinline__ float operator()(int row, int col, f32x4 v0, f32x4 v1) const {
        const float r = rsqrtf(ssq_kv[row] * (1.f / KVR) + EPS); v0 = v0 * r; v1 = v1 * r;
        const int h = col >> 7, w = col & 127;
        if (w < 64) {
            store8bf(k + (size_t)row * 768 + h * DQK + w, v0, v1);
            if (w < 32) *(u32x4*)(k + (size_t)row * 768 + h * DQK + 64 + w) = *(const u32x4*)(proj + (size_t)row * 512 + 384 + w);
        } else store8bf(v + (size_t)row * 512 + h * DV + (w - 64), v0, v1);
        return 0.f;
    }
};
struct EpiLst {
    float* lst;
    __device__ __forceinline__ float* ssq(int) const { return nullptr; }
    __device__ __forceinline__ float operator()(int row, int col, f32x4 v0, f32x4 v1) const {
        float* o = lst + (size_t)row * 8192 + col; *(f32x4*)o = v0; *(f32x4*)(o + 4) = v1; return 0.f;
    }
};
struct EpiSsmOut {
    bf16_t* g;
    __device__ __forceinline__ float* ssq(int) const { return nullptr; }
    __device__ __forceinline__ float operator()(int row, int col, f32x4 v0, f32x4 v1) const {
        const int grp = col >> 8, t = (col >> 4) & 15, h0 = col & 15;
#pragma unroll
        for (int i = 0; i < 4; ++i) { v0[i] = gelu_tanh(v0[i]); v1[i] = gelu_tanh(v1[i]); }
        store8bf(g + ((size_t)row * 16 + t) * 512 + grp * 16 + h0, v0, v1); return 0.f;
    }
};
struct EpiGlu {
    const bf16_t* g; const float* bias; bf16_t* mix; float* ssq_s;
    __device__ __forceinline__ float* ssq(int) const { return ssq_s; }
    __device__ __forceinline__ float operator()(int row, int col, f32x4 v0, f32x4 v1) const {
        f32x4 g0, g1; load8bf(g + (size_t)row * 512 + col, g0, g1);
        const f32x4 b0 = *(const f32x4*)(bias + col), b1 = *(const f32x4*)(bias + col + 4);
#pragma unroll
        for (int i = 0; i < 4; ++i) { v0[i] = g0[i] / (1.f + __expf(-(v0[i] + b0[i]))); v1[i] = g1[i] / (1.f + __expf(-(v1[i] + b1[i]))); }
        store8bf(mix + (size_t)row * 1024 + 512 + col, v0, v1); return sumsq8(v0, v1);
    }
};
struct EpiOut {
    const float* xp; const float* xs; const float* ssq_s; float* x1; bf16_t* x1b; float* ssq_x1;
    __device__ __forceinline__ float* ssq(int) const { return ssq_x1; }
    __device__ __forceinline__ float operator()(int row, int col, f32x4 v0, f32x4 v1) const {
        const float r = rsqrtf(ssq_s[row] * (1.f / 512) + EPS);
        const float* xr = (row < M_PROMPT ? xp + (size_t)row * DM : xs + (size_t)(row - M_PROMPT) * DM) + col;
        v0 = *(const f32x4*)xr + v0 * r; v1 = *(const f32x4*)(xr + 4) + v1 * r;
        float* o = x1 + (size_t)row * DM + col; *(f32x4*)o = v0; *(f32x4*)(o + 4) = v1;
        store8bf(x1b + (size_t)row * DM + col, v0, v1); return sumsq8(v0, v1);
    }
};
struct EpiMlp1 {
    const float* ssq_x1; bf16_t* hb; int r0, pad;
    __device__ __forceinline__ float* ssq(int) const { return nullptr; }
    __device__ __forceinline__ float operator()(int row, int col, f32x4 v0, f32x4 v1) const {
        const float r = rsqrtf(ssq_x1[r0 + row] * (1.f / DM) + EPS);
#pragma unroll
        for (int i = 0; i < 4; ++i) { float a = fmaxf(v0[i] * r, 0.f), b = fmaxf(v1[i] * r, 0.f); v0[i] = a * a; v1[i] = b * b; }
        store8bf(hb + (size_t)row * DFF + col, v0, v1); return 0.f;
    }
};
struct EpiMlp2 {
    const float* xin; float* xout; float* ssq_x2; int r0, pad;
    __device__ __forceinline__ float* ssq(int) const { return ssq_x2; }
    __device__ __forceinline__ float operator()(int row, int col, f32x4 v0, f32x4 v1) const {
        const float* i = xin + (size_t)row * DM + col; float* o = xout + (size_t)row * DM + col;
        v0 = *(const f32x4*)i + v0; v1 = *(const f32x4*)(i + 4) + v1;
        *(f32x4*)o = v0; *(f32x4*)(o + 4) = v1; return sumsq8(v0, v1);
    }
};


namespace pg8 {
constexpr int BM = 256, BK = 64, HALF = 128, HTB = HALF * BK * 2, STAGE_BYTES = 8 * HTB, NXCD = 8, WGM = 8;
__host__ __device__ __forceinline__ int lds_byte(int r, int c) { const int st = (r >> 4) * 2 + (c >> 5), rr = r & 15, cc = c & 31, ob = rr * 64 + cc * 2; return st * 1024 + (ob ^ (((ob >> 9) & 1) << 5)); }
__host__ __device__ __forceinline__ void stage_rc(int b, int& R, int& C) { const int st = b / 1024, sb = b % 1024, swz = sb ^ (((sb >> 9) & 1) << 5); R = (st >> 1) * 16 + swz / 64; C = (st & 1) * 32 + (swz % 64) / 2; }
struct Unit { int pm, pn; };
struct Gemm { const bf16_t* A; const bf16_t* Bt; int M, N, K, lda, ldb, a_pn_off, resc_t; const float* ssa; const float* sss; };
struct StaticOrder {
    int nM, nN, nwg, G, c;
    __device__ void init(int M, int N, int G_, int c_) { nM = M / BM; nN = N / BM; nwg = nM * nN; G = G_; c = c_; }
    __device__ bool next(int i, Unit& u) const {
        const long L = (long)i * G + c; if (L >= nwg) return false;
        int wgid = (int)L; { const int q = nwg / NXCD, r = nwg % NXCD, xcd = wgid % NXCD, off = wgid / NXCD; wgid = (xcd < r ? xcd * (q + 1) : r * (q + 1) + (xcd - r) * q) + off; }
        const int nig = WGM * nN, gid = wgid / nig, fm = gid * WGM, gsz = (nM - fm) < WGM ? (nM - fm) : WGM;
        u.pm = fm + ((wgid % nig) % gsz); u.pn = (wgid % nig) / gsz; return true;
    }
};
template <class E> struct EpiW {
    E e;
    __device__ __forceinline__ void operator()(const f32x4 (&acc)[2][2][4][2], const Unit& u, int wr, int wc, int fr, int fq) const {
        float* tgt = e.ssq(u.pn);
#pragma unroll
        for (int ai = 0; ai < 2; ++ai)
#pragma unroll
            for (int m = 0; m < 4; ++m) {
                int row = u.pm * BM + ai * HALF + wr * 64 + m * 16 + fr; asm volatile("" : "+v"(row)); float s = 0.f;
#pragma unroll
                for (int bj = 0; bj < 2; ++bj) s += e(row, u.pn * BM + bj * HALF + wc * 32 + 8 * fq, acc[ai][bj][m][0], acc[ai][bj][m][1]);
                if (tgt) { s += __shfl_xor(s, 16); s += __shfl_xor(s, 32); if (fq == 0) atomicAdd(tgt + row, s); }
                asm volatile("" ::: "memory");
            }
    }
};
template <class Epi>
__device__ __forceinline__ void gemm_phase(LAS unsigned char* lds, const Gemm g, const StaticOrder& S, const Epi& E) {
    int tid = threadIdx.x; asm volatile("" : "+v"(tid));
    const int wid = __builtin_amdgcn_readfirstlane(tid >> 6), lane = tid & 63, wr = wid >> 2, wc = wid & 3, fr = lane & 15, fq = lane >> 4;
    const int K = g.K, nt = K / BK;
    unsigned voffA[2], voffB[2];
#pragma unroll
    for (int i = 0; i < 2; ++i) { int R, C; stage_rc(tid * 16 + i * 8192, R, C); const int Rb = (R & ~31) + perm32(R & 31);
        voffA[i] = (unsigned)(R * g.lda + C) * 2u; voffB[i] = (unsigned)(Rb * g.ldb + C) * 2u; }
    const size_t kstep = (size_t)(BK * 2);
    const size_t hstepA = (size_t)HALF * g.lda * 2, hstepB = (size_t)HALF * g.ldb * 2;
    const size_t tstepA = 2 * hstepA, tstepB = 2 * hstepB, pstepA = (size_t)g.a_pn_off * 2;
    const unsigned ldsw = (unsigned)wid * 1024u;
    const int aoff = lds_byte(wr * 64 + fr, fq * 8), boff = lds_byte(wc * 32 + fr, fq * 8);
#define PG8_SA(b, h) (((b) * 2 + (h)) * HTB)
#define PG8_SB(b, h) ((4 + (b) * 2 + (h)) * HTB)
#define PG8_STAGE(bufoff, gbase, voff) do { _Pragma("unroll") for (int _i = 0; _i < 2; ++_i) \
        __builtin_amdgcn_global_load_lds((const unsigned*)((const char*)(gbase) + (voff)[_i]), (LAS unsigned*)(lds + (bufoff) + ldsw + _i * 8192), 16, 0, 0); } while (0)
#define PG8_LDA(dst, b, h) do { _Pragma("unroll") for (int m = 0; m < 4; ++m) _Pragma("unroll") for (int k = 0; k < 2; ++k) dst[m][k] = *(const LAS bf16x8*)(lds + PG8_SA(b, h) + aoff + m * 2048 + k * 1024); } while (0)
#define PG8_LDB(dst, b, h) do { _Pragma("unroll") for (int n = 0; n < 2; ++n) _Pragma("unroll") for (int k = 0; k < 2; ++k) dst[n][k] = *(const LAS bf16x8*)(lds + PG8_SB(b, h) + boff + n * 2048 + k * 1024); } while (0)
#define PG8_MMA(ai, bj, At, Bt) do { __builtin_amdgcn_s_setprio(1); _Pragma("unroll") for (int m = 0; m < 4; ++m) _Pragma("unroll") for (int n = 0; n < 2; ++n) _Pragma("unroll") for (int k = 0; k < 2; ++k) \
        acc[ai][bj][m][n] = __builtin_amdgcn_mfma_f32_16x16x32_bf16(Bt[n][k], At[m][k], acc[ai][bj][m][n], 0, 0, 0); __builtin_amdgcn_s_setprio(0); } while (0)
#define PG8_WAIT_V(n) asm volatile("s_waitcnt vmcnt(" #n ")" ::: "memory")
#define PG8_WAIT_L(n) asm volatile("s_waitcnt lgkmcnt(" #n ")" ::: "memory")
#define PG8_BAR __builtin_amdgcn_s_barrier()
#define PG8_SCHED __builtin_amdgcn_sched_barrier(0)
    Unit cur, nxt; int ui = 0;
    if (!S.next(0, cur)) return;
    f32x4 acc[2][2][4][2];
#pragma unroll
    for (int a = 0; a < 2; ++a)
#pragma unroll
        for (int b = 0; b < 2; ++b)
#pragma unroll
            for (int m = 0; m < 4; ++m)
#pragma unroll
                for (int n = 0; n < 2; ++n) acc[a][b][m][n] = (f32x4){0.f, 0.f, 0.f, 0.f};
    bf16x8 At[4][2], B0[2][2], B1[2][2];
    const char* cA = (const char*)g.A + (size_t)cur.pm * tstepA + (size_t)cur.pn * pstepA; const char* cB = (const char*)g.Bt + (size_t)cur.pn * tstepB;
    PG8_STAGE(PG8_SB(0, 0), cB, voffB); PG8_STAGE(PG8_SB(0, 1), cB + hstepB, voffB); PG8_STAGE(PG8_SA(0, 0), cA, voffA); PG8_STAGE(PG8_SA(0, 1), cA + hstepA, voffA);
    if (wr == 1) PG8_BAR;
    PG8_WAIT_V(2); PG8_BAR;
    PG8_STAGE(PG8_SB(1, 0), cB + kstep, voffB); PG8_STAGE(PG8_SA(1, 0), cA + kstep, voffA); PG8_STAGE(PG8_SB(1, 1), cB + hstepB + kstep, voffB);
    PG8_WAIT_V(6); PG8_BAR;
    for (;;) {
        const bool has_next = S.next(ui + 1, nxt);
        const char* nA = has_next ? (const char*)g.A + (size_t)nxt.pm * tstepA + (size_t)nxt.pn * pstepA : cA; const char* nB = has_next ? (const char*)g.Bt + (size_t)nxt.pn * tstepB : cB;
        for (int t = 0; t < nt; t += 2) {
            const bool last = (t == nt - 2);
            const char* a1 = cA + (size_t)(t + 1) * kstep;
            const char* a2 = last ? nA : cA + (size_t)(t + 2) * kstep; const char* b2 = last ? nB : cB + (size_t)(t + 2) * kstep;
            const char* a3 = a2 + kstep; const char* b3 = b2 + kstep;
            if (t == g.resc_t) {
#pragma unroll
                for (int ai = 0; ai < 2; ++ai)
#pragma unroll
                    for (int m = 0; m < 4; ++m) { int row = cur.pm * BM + ai * HALF + wr * 64 + m * 16 + fr; asm volatile("" : "+v"(row));
                        const float f = sqrtf((g.sss[row] * (1.f / 512) + EPS) / (g.ssa[row] * (1.f / 512) + EPS));
#pragma unroll
                        for (int bj = 0; bj < 2; ++bj) { acc[ai][bj][m][0] = acc[ai][bj][m][0] * f; acc[ai][bj][m][1] = acc[ai][bj][m][1] * f; }
                        asm volatile("" ::: "memory"); }
            }
            PG8_LDB(B0, 0, 0); PG8_LDB(B1, 0, 1); PG8_SCHED; PG8_LDA(At, 0, 0); PG8_STAGE(PG8_SA(1, 1), a1 + hstepA, voffA);
            PG8_WAIT_V(8); PG8_WAIT_L(0); PG8_BAR; PG8_MMA(0, 0, At, B0); PG8_MMA(0, 1, At, B1); PG8_BAR; PG8_SCHED;
            PG8_LDA(At, 0, 1); PG8_STAGE(PG8_SB(0, 0), b2, voffB); PG8_STAGE(PG8_SB(0, 1), b2 + hstepB, voffB); PG8_STAGE(PG8_SA(0, 0), a2, voffA);
            PG8_WAIT_V(8); PG8_WAIT_L(0); PG8_BAR; PG8_MMA(1, 0, At, B0); PG8_MMA(1, 1, At, B1); PG8_BAR; PG8_SCHED;
            PG8_LDB(B0, 1, 0); PG8_LDB(B1, 1, 1); PG8_SCHED; PG8_LDA(At, 1, 0); PG8_STAGE(PG8_SA(0, 1), a2 + hstepA, voffA);
            PG8_WAIT_V(8); PG8_WAIT_L(0); PG8_BAR; PG8_MMA(0, 0, At, B0); PG8_MMA(0, 1, At, B1); PG8_BAR; PG8_SCHED;
            PG8_LDA(At, 1, 1); PG8_STAGE(PG8_SB(1, 0), b3, voffB); PG8_STAGE(PG8_SB(1, 1), b3 + hstepB, voffB); PG8_STAGE(PG8_SA(1, 0), a3, voffA);
            PG8_WAIT_V(8); PG8_WAIT_L(0); PG8_BAR; PG8_MMA(1, 0, At, B0); PG8_MMA(1, 1, At, B1); PG8_BAR; PG8_SCHED;
        }
        if (wr == 0) PG8_BAR;
        E(acc, cur, wr, wc, fr, fq);
        if (!has_next) break;
#pragma unroll
        for (int a = 0; a < 2; ++a)
#pragma unroll
            for (int b = 0; b < 2; ++b)
#pragma unroll
                for (int m = 0; m < 4; ++m)
#pragma unroll
                    for (int n = 0; n < 2; ++n) acc[a][b][m][n] = (f32x4){0.f, 0.f, 0.f, 0.f};
        cur = nxt; cA = nA; cB = nB; ++ui;
        if (wr == 1) PG8_BAR;
    }
    PG8_WAIT_V(0);
    PG8_BAR;
#undef PG8_SA
#undef PG8_SB
#undef PG8_STAGE
#undef PG8_LDA
#undef PG8_LDB
#undef PG8_MMA
#undef PG8_WAIT_V
#undef PG8_WAIT_L
#undef PG8_BAR
#undef PG8_SCHED
}
template <class E>
__device__ __forceinline__ void run_gemm(LAS unsigned char* lds, const bf16_t* A, int lda, int a_pn_off, const bf16_t* Bt, int ldb, int M, int N, int K, const E& e, int G, int bx,
                                         int resc_t = -1, const float* ssa = nullptr, const float* sss = nullptr) {
    Gemm g{A, Bt, M, N, K, lda, ldb, a_pn_off, resc_t, ssa, sss};
    StaticOrder S; S.init(M, N, G, bx);
    EpiW<E> W{e};
    gemm_phase<EpiW<E>>(lds, g, S, W);
}
}

template <class E>
__global__ __launch_bounds__(256) void naive_gemm(const bf16_t* A, int lda, int a_pn_off, const bf16_t* Bt, int ldb, int M, int N, int K, E e, int resc_k, const float* ssa, const float* sss) {
    const int lane = threadIdx.x & 63, wid = threadIdx.x >> 6, fr = lane & 15, fq = lane >> 4;
    const int nct = N / 32, ntask = (M / 64) * nct;
    for (int task = blockIdx.x * 4 + wid; task < ntask; task += gridDim.x * 4) {
        const int rt = task / nct, ct = task % nct, pn = (ct * 32) >> 8;
        const bf16_t* Ab = A + (size_t)pn * a_pn_off + (size_t)(rt * 64 + fr) * lda + fq * 8;
        const bf16_t* Wb0 = Bt + (size_t)(ct * 32 + perm32(fr)) * ldb + fq * 8;
        const bf16_t* Wb1 = Bt + (size_t)(ct * 32 + perm32(16 + fr)) * ldb + fq * 8;
        f32x4 acc[4][2];
#pragma unroll
        for (int m = 0; m < 4; ++m) { acc[m][0] = (f32x4){0, 0, 0, 0}; acc[m][1] = (f32x4){0, 0, 0, 0}; }
        for (int k0 = 0; k0 < K; k0 += 32) {
            if (k0 == resc_k) {
#pragma unroll
                for (int m = 0; m < 4; ++m) { const int row = rt * 64 + m * 16 + fr; const float f = sqrtf((sss[row] * (1.f / 512) + EPS) / (ssa[row] * (1.f / 512) + EPS)); acc[m][0] = acc[m][0] * f; acc[m][1] = acc[m][1] * f; }
            }
            const bf16x8 w0 = *(const bf16x8*)(Wb0 + k0), w1 = *(const bf16x8*)(Wb1 + k0);
#pragma unroll
            for (int m = 0; m < 4; ++m) {
                const bf16x8 a = *(const bf16x8*)(Ab + (size_t)m * 16 * lda + k0);
                acc[m][0] = __builtin_amdgcn_mfma_f32_16x16x32_bf16(w0, a, acc[m][0], 0, 0, 0);
                acc[m][1] = __builtin_amdgcn_mfma_f32_16x16x32_bf16(w1, a, acc[m][1], 0, 0, 0);
            }
        }
        float* tgt = e.ssq(pn);
#pragma unroll
        for (int m = 0; m < 4; ++m) {
            const int row = rt * 64 + m * 16 + fr;
            float s = e(row, ct * 32 + 8 * fq, acc[m][0], acc[m][1]);
            if (tgt) { s += __shfl_xor(s, 16); s += __shfl_xor(s, 32); if (fq == 0) atomicAdd(tgt + row, s); }
        }
    }
}

__global__ __launch_bounds__(256) void naive_attn(const bf16_t* __restrict__ Q, const bf16_t* __restrict__ K, const bf16_t* __restrict__ V, bf16_t* __restrict__ mix, float* __restrict__ ssq_a) {
    const int h = blockIdx.y, row = blockIdx.x * 256 + threadIdx.x;
    const int s0 = row < M_PROMPT ? (blockIdx.x * 256 / SEQ_P) * SEQ_P : M_PROMPT, len = row < M_PROMPT ? SEQ_P : SEQ_S;
    float q[DQK], o[DV];
#pragma unroll
    for (int d = 0; d < DQK; ++d) q[d] = bf2f(Q[(size_t)row * 768 + h * DQK + d]);
#pragma unroll
    for (int d = 0; d < DV; ++d) o[d] = 0.f;
    float m = -1e30f, l = 0.f;
    for (int j = 0; j < len; ++j) {
        const bf16_t* kp = K + (size_t)(s0 + j) * 768 + h * DQK; const bf16_t* vp = V + (size_t)(s0 + j) * 512 + h * DV;
        float s = 0.f;
#pragma unroll
        for (int d = 0; d < DQK; ++d) s += q[d] * bf2f(kp[d]);
        if (s > m) { const float a = exp2f(m - s); l *= a;
#pragma unroll
            for (int d = 0; d < DV; ++d) o[d] *= a;
            m = s; }
        const float p = exp2f(s - m); l += p;
#pragma unroll
        for (int d = 0; d < DV; ++d) o[d] += p * bf2f(vp[d]);
    }
    const float il = 1.f / l; float ss = 0.f;
#pragma unroll
    for (int d = 0; d < DV; ++d) { o[d] *= il; ss += o[d] * o[d]; }
#pragma unroll
    for (int d = 0; d < DV; d += 2) *(unsigned*)(mix + (size_t)row * 1024 + h * DV + d) = pk2(o[d], o[d + 1]);
    atomicAdd(ssq_a + row, ss);
}

__global__ __launch_bounds__(64) void naive_ssm(const bf16_t* __restrict__ ua, float* __restrict__ Y, int dir, const float* lam_re, const float* lam_im, const float* log_dt,
                                                const float* b_re, const float* b_im, const float* c_re, const float* c_im, const float* d_skip) {
    const int n = threadIdx.x, g = blockIdx.x & 31, sq = blockIdx.x >> 5;
    const int s0 = sq < 8 ? sq * SEQ_P : M_PROMPT, len = sq < 8 ? SEQ_P : SEQ_S;
    const int pi = (dir * NG + g) * NS + n;
    const float lr = lam_re[pi], li = lam_im[pi], dt = expf(log_dt[dir * NG + g]);
    const float mag = expf(lr * dt); float sn, cs; sincosf(li * dt, &sn, &cs);
    const float ar = mag * cs, ai = mag * sn;
    const float nr = ar - 1.f, ni = ai, den = lr * lr + li * li;
    const float fr_ = (nr * lr + ni * li) / den, fi_ = (ni * lr - nr * li) / den;
    float bbr[GH], bbi[GH], cr[GH], ci[GH];
#pragma unroll
    for (int h = 0; h < GH; ++h) {
        const float br = b_re[(size_t)pi * GH + h], bi = b_im[(size_t)pi * GH + h];
        bbr[h] = fr_ * br - fi_ * bi; bbi[h] = fr_ * bi + fi_ * br;
        cr[h] = c_re[((size_t)(dir * NG + g) * GH + h) * NS + n]; ci[h] = c_im[((size_t)(dir * NG + g) * GH + h) * NS + n];
    }
    const int hsel = ((n >> 5) & 1) * 8 + ((n >> 4) & 1) * 4 + ((n >> 3) & 1) * 2 + ((n >> 2) & 1);
    float xr = 0.f, xi = 0.f;
    const int nch = len / CT, c0 = s0 / CT;
    for (int cc = 0; cc < nch; ++cc) {
        const int chunk = c0 + (dir == 0 ? cc : nch - 1 - cc);
        const u32x2 raw = *(const u32x2*)(ua + ((size_t)chunk * 32 + g) * 512 + n * 4);
        float uv[4]; uv[0] = __builtin_bit_cast(float, raw.x << 16); uv[1] = __builtin_bit_cast(float, raw.x & 0xffff0000u);
        uv[2] = __builtin_bit_cast(float, raw.y << 16); uv[3] = __builtin_bit_cast(float, raw.y & 0xffff0000u);
#pragma unroll
        for (int tt = 0; tt < CT; ++tt) {
            const int t = dir == 0 ? tt : CT - 1 - tt;
            float u[GH];
#pragma unroll
            for (int h = 0; h < GH; ++h) u[h] = __shfl(uv[h & 3], t * 4 + (h >> 2));
            float bur = 0.f, bui = 0.f;
#pragma unroll
            for (int h = 0; h < GH; ++h) { bur += bbr[h] * u[h]; bui += bbi[h] * u[h]; }
            const float nxr = ar * xr - ai * xi + bur, nxi = ar * xi + ai * xr + bui; xr = nxr; xi = nxi;
            float v[GH];
#pragma unroll
            for (int h = 0; h < GH; ++h) v[h] = cr[h] * xr - ci[h] * xi;
#pragma unroll
            for (int i = 0; i < 8; ++i) { const bool up = n & 32; const float send = up ? v[i] : v[i + 8], keep = up ? v[i + 8] : v[i]; v[i] = keep + __shfl_xor(send, 32); }
#pragma unroll
            for (int i = 0; i < 4; ++i) { const bool up = n & 16; const float send = up ? v[i] : v[i + 4], keep = up ? v[i + 4] : v[i]; v[i] = keep + __shfl_xor(send, 16); }
#pragma unroll
            for (int i = 0; i < 2; ++i) { const bool up = n & 8; const float send = up ? v[i] : v[i + 2], keep = up ? v[i + 2] : v[i]; v[i] = keep + __shfl_xor(send, 8); }
            { const bool up = n & 4; const float send = up ? v[0] : v[1], keep = up ? v[1] : v[0]; v[0] = keep + __shfl_xor(send, 4); }
            v[0] += __shfl_xor(v[0], 2); v[0] += __shfl_xor(v[0], 1);
            if ((n & 3) == 0) {
                float* yp = Y + (size_t)(chunk * CT + t) * SSMW + g * GH + hsel;
                if (dir == 0) *yp = v[0]; else *yp += v[0];
            }
        }
    }
}
__global__ __launch_bounds__(256) void naive_ssm_finish(const float* __restrict__ Y, const bf16_t* __restrict__ ua, const float* __restrict__ d_skip, bf16_t* __restrict__ G) {
    const size_t i = (size_t)blockIdx.x * 256 + threadIdx.x;
    if (i < (size_t)M_TOK * SSMW) {
        const int row = (int)(i >> 9), col = (int)(i & 511), g = col >> 4, h = col & 15;
        const float u = bf2f(ua[((size_t)(row >> 4) * 32 + g) * 512 + (row & 15) * 16 + h]);
        G[i] = (bf16_t)f2bf(gelu_tanh(Y[i] + d_skip[col] * u));
    }
}

__device__ __forceinline__ void final_norm_rows(float* out, const float* ssq_x2, const float* fg, int gw, int ngw, int lane) {
    for (int m = gw; m < M_TOK; m += ngw) {
        const float r = rsqrtf(ssq_x2[m] * (1.f / DM) + EPS);
        f32x4* o = (f32x4*)(out + (size_t)m * DM) + lane;
#pragma unroll
        for (int j = 0; j < 4; ++j) { const f32x4 g = *((const f32x4*)fg + lane + 64 * j); o[64 * j] = o[64 * j] * r * g; }
    }
}
__global__ __launch_bounds__(256) void naive_final(float* out, const float* ssq_x2, const float* fg) {
    final_norm_rows(out, ssq_x2, fg, blockIdx.x * 4 + (threadIdx.x >> 6), gridDim.x * 4, threadIdx.x & 63);
}

constexpr int NWAVES = 8;
template <class MAP>
__device__ __forceinline__ void transpose_item(const float* W, int K, int N, bf16_t* WT, LAS float* scr, int item, int lane, int nblk, const MAP& map, const float* gain0, const float* gain1, int gsplit) {
    const int kb = item / nblk, nb = item % nblk, k0 = 64 * kb, n0 = 32 * nb;
    const int sc = map(n0 + (lane & 31));
#pragma unroll 8
    for (int i = 0; i < 32; ++i) {
        const int kk = 2 * i + (lane >> 5), k = k0 + kk;
        float v = sc >= 0 ? W[(size_t)k * N + sc] : 0.f;
        if (gain0) v *= (k < gsplit ? gain0[k] : gain1[k - gsplit]);
        scr[kk * 33 + (lane & 31)] = v;
    }
    asm volatile("s_waitcnt lgkmcnt(0)" ::: "memory");
    const int c = lane & 7;
#pragma unroll
    for (int j = 0; j < 4; ++j) {
        const int n = (lane >> 3) + 8 * j; const LAS float* s = scr + (8 * c) * 33 + n;
        u32x4 o; o.x = pk2(s[0 * 33], s[1 * 33]); o.y = pk2(s[2 * 33], s[3 * 33]); o.z = pk2(s[4 * 33], s[5 * 33]); o.w = pk2(s[6 * 33], s[7 * 33]);
        *(u32x4*)(WT + (size_t)(n0 + n) * K + k0 + 8 * c) = o;
    }
    asm volatile("s_waitcnt lgkmcnt(0)" ::: "memory");
}
struct MapId { __device__ __forceinline__ int operator()(int n) const { return n; } };
struct MapWin { __device__ __forceinline__ int operator()(int n) const { if (n < 384) return n; if (n < 416) return 384 + rope_logical(n - 384); if (n < 512) return -1; return 416 + (n - 512); } };
struct MapWuq { __device__ __forceinline__ int operator()(int n) const { const int h = n / DQK, d = n % DQK; return h * DQK + (d < DNOPE ? d : DNOPE + rope_logical(d - DNOPE)); } };

struct cpx { float r, i; };
__device__ __forceinline__ cpx cmul(cpx a, cpx b) { return {a.r * b.r - a.i * b.i, a.r * b.i + a.i * b.r}; }
__device__ __forceinline__ cpx apow(float lr, float li, float dt, float p) { const float mag = expf(lr * dt * p); float sn, cs; sincosf(li * dt * p, &sn, &cs); return {mag * cs, mag * sn}; }
__device__ __forceinline__ cpx bfac(float lr, float li, float dt) {
    const cpx a = apow(lr, li, dt, 1.f); const float nr = a.r - 1.f, ni = a.i, den = lr * lr + li * li;
    return {(nr * lr + ni * li) / den, (ni * lr - nr * li) / den};
}

__device__ __forceinline__ void prologue(const Params& p, LAS unsigned char* lds, int vcu, int G) {
    const int tid = threadIdx.x, lane = tid & 63, wave = tid >> 6;
    const int gw = vcu * NWAVES + wave, NGW = G * NWAVES;
    unsigned char* ws = p.ws;
    LAS float* scr = (LAS float*)(lds + wave * 16384);
    {
        constexpr int I_WIN = 16 * 32, I_WUQ = 4 * 24, I_WUKV = 2 * 32, I_WGLU = 8 * 16, I_WOUT = 16 * 32, I_W1 = 16 * 128, I_W2 = 64 * 32;
        constexpr int NITEMS = I_WIN + I_WUQ + I_WUKV + I_WGLU + I_WOUT + I_W1 + I_W2;
        for (int it = gw; it < NITEMS; it += NGW) {
            int r = it;
            if (r < I_WIN) { transpose_item(p.in[3], 1024, INW, (bf16_t*)(ws + WS_WIN), scr, r, lane, 32, MapWin(), p.in[2], p.in[2], 1 << 30); continue; } r -= I_WIN;
            if (r < I_WUQ) { transpose_item(p.in[5], 256, 768, (bf16_t*)(ws + WS_WUQ), scr, r, lane, 24, MapWuq(), p.in[4], p.in[4], 1 << 30); continue; } r -= I_WUQ;
            if (r < I_WUKV) { transpose_item(p.in[7], 128, 1024, (bf16_t*)(ws + WS_WUKV), scr, r, lane, 32, MapId(), p.in[6], p.in[6], 1 << 30); continue; } r -= I_WUKV;
            if (r < I_WGLU) { transpose_item(p.in[16], 512, 512, (bf16_t*)(ws + WS_WGLU), scr, r, lane, 16, MapId(), nullptr, nullptr, 0); continue; } r -= I_WGLU;
            if (r < I_WOUT) { transpose_item(p.in[20], 1024, 1024, (bf16_t*)(ws + WS_WOUT), scr, r, lane, 32, MapId(), p.in[18], p.in[19], 512); continue; } r -= I_WOUT;
            if (r < I_W1) { transpose_item(p.in[22], 1024, 4096, (bf16_t*)(ws + WS_W1), scr, r, lane, 128, MapId(), p.in[21], p.in[21], 1 << 30); continue; } r -= I_W1;
            transpose_item(p.in[23], 4096, 1024, (bf16_t*)(ws + WS_W2), scr, r, lane, 32, MapId(), nullptr, nullptr, 0);
        }
    }
    {
        float* stat = (float*)(ws + WS_STAT); bf16_t* xb = (bf16_t*)(ws + WS_XB);
        for (int m = gw; m < M_TOK; m += NGW) {
            const float* xrow = m < M_PROMPT ? p.in[0] + (size_t)m * DM : p.in[1] + (size_t)(m - M_PROMPT) * DM;
            const f32x4* xr = (const f32x4*)xrow + lane;
            f32x4 v[4]; float s = 0.f;
#pragma unroll
            for (int j = 0; j < 4; ++j) { v[j] = xr[64 * j]; s += (v[j].x * v[j].x + v[j].y * v[j].y) + (v[j].z * v[j].z + v[j].w * v[j].w); }
            s = wave_sum(s);
            unsigned long long* o8 = (unsigned long long*)(xb + (size_t)m * DM) + lane;
#pragma unroll
            for (int j = 0; j < 4; ++j) o8[64 * j] = (unsigned long long)pk2(v[j].x, v[j].y) | ((unsigned long long)pk2(v[j].z, v[j].w) << 32);
            if (lane == 0) stat[ST_RSTD1 * M_TOK + m] = rsqrtf(s * (1.f / DM) + EPS);
            else if (lane < 7) stat[lane * M_TOK + m] = 0.f;
        }
    }
    {
        float* cosT = (float*)(ws + WS_ROPE); float* sinT = cosT + SEQ_S * 16;
        for (int i = gw * 64 + lane; i < SEQ_S * 16; i += NGW * 64) {
            const int pos = i >> 4, j = i & 15;
            const float inv = powf(10000.f, -(float)(2 * j) / 32.f);
            const float ang = (float)pos * inv; float sn, cs; sincosf(ang, &sn, &cs);
            cosT[i] = cs; sinT[i] = sn;
        }
    }
    {
        const float* lam_re = p.in[8]; const float* lam_im = p.in[9]; const float* log_dt = p.in[10];
        const float* b_re = p.in[11]; const float* b_im = p.in[12]; const float* c_re = p.in[13]; const float* c_im = p.in[14]; const float* d_skip = p.in[15];
        bf16_t* MQ = (bf16_t*)(ws + WS_MQ); bf16_t* SP = (bf16_t*)(ws + WS_SP); float* AT = (float*)(ws + WS_AT);
        for (int it = gw; it < NG * CT * 2; it += NGW) {
            const int dir = it & 1, k = (it >> 1) & 15, g = it >> 5;
            if (k == 0 && dir == 1) continue;
            const int h = lane >> 2, hp0 = (lane & 3) * 4;
            float e[4] = {0.f, 0.f, 0.f, 0.f};
            const int ndir = (k == 0) ? 2 : 1;
            for (int dd = 0; dd < ndir; ++dd) {
                const int d = (k == 0) ? dd : dir;
                const int pi = (d * NG + g) * NS + lane;
                const float lr = lam_re[pi], li = lam_im[pi], dt = expf(log_dt[d * NG + g]);
                const cpx coef = cmul(apow(lr, li, dt, (float)k), bfac(lr, li, dt));
                for (int n = 0; n < NS; ++n) {
                    const cpx cf = {__shfl(coef.r, n), __shfl(coef.i, n)};
                    const size_t ci_ = ((size_t)(d * NG + g) * GH + h) * NS + n;
                    const cpx cc = cmul({c_re[ci_], c_im[ci_]}, cf);
                    const size_t bi_ = ((size_t)(d * NG + g) * NS + n) * GH + hp0;
#pragma unroll
                    for (int q = 0; q < 4; ++q) e[q] += cc.r * b_re[bi_ + q] - cc.i * b_im[bi_ + q];
                }
            }
            if (k == 0) {
#pragma unroll
                for (int q = 0; q < 4; ++q) if (hp0 + q == h) e[q] += d_skip[g * GH + h];
            }
            const unsigned long long w = (unsigned long long)pk2(e[0], e[1]) | ((unsigned long long)pk2(e[2], e[3]) << 32);
            for (int t = 0; t < CT; ++t) {
                const int j = (k == 0) ? t : (dir == 0 ? t - k : t + k);
                if (j < 0 || j >= CT) continue;
                *(unsigned long long*)(MQ + ((size_t)g * 256 + t * 16 + h) * 512 + j * 16 + hp0) = w;
            }
        }
        for (int i = gw * 64 + lane; i < NG * 256 * 256; i += NGW * 64) {
            const int s = i & 255, rr = (i >> 8) & 255, g = i >> 16;
            const int dir = s >> 7, part = (s >> 6) & 1, n = s & 63;
            const int pi = (dir * NG + g) * NS + n;
            const float lr = lam_re[pi], li = lam_im[pi], dt = expf(log_dt[dir * NG + g]);
            {
                const int t = rr >> 4, h = rr & 15;
                const cpx a = apow(lr, li, dt, (float)(dir == 0 ? t + 1 : CT - t));
                const size_t ci_ = ((size_t)(dir * NG + g) * GH + h) * NS + n;
                const cpx v = cmul({c_re[ci_], c_im[ci_]}, a);
                MQ[((size_t)g * 256 + rr) * 512 + 256 + s] = (bf16_t)f2bf(part == 0 ? v.r : -v.i);
            }
            {
                const int j = rr >> 4, hp = rr & 15;
                const cpx a = cmul(apow(lr, li, dt, (float)(dir == 0 ? CT - 1 - j : j)), bfac(lr, li, dt));
                const size_t bi_ = ((size_t)(dir * NG + g) * NS + n) * GH + hp;
                const cpx v = cmul(a, {b_re[bi_], b_im[bi_]});
                SP[((size_t)g * 256 + s) * 256 + rr] = (bf16_t)f2bf(part == 0 ? v.r : v.i);
            }
        }
        for (int i = gw * 64 + lane; i < 2 * NG * NS; i += NGW * 64) {
            const float lr = lam_re[i], li = lam_im[i], dt = expf(log_dt[i >> 6]);
            const cpx a = apow(lr, li, dt, (float)CT); AT[2 * i] = a.r; AT[2 * i + 1] = a.i;
        }
    }
}


namespace att {
using s16x4 = __attribute__((ext_vector_type(4))) short;
using f32x16 = __attribute__((ext_vector_type(16))) float;
typedef short v4i16_t __attribute__((ext_vector_type(4)));
constexpr int QBLK = 32, KVBLK = 64, NSLOT = 3;
constexpr int SHM_V = KVBLK * DV * 2, SHM_K = KVBLK * DQK * 2;
constexpr int OFF_V = 0, OFF_K = NSLOT * SHM_V, OFF_WS = NSLOT * (SHM_V + SHM_K);
constexpr float THRL = 8.f;
#define SBAR() __builtin_amdgcn_sched_barrier(0)
__device__ __forceinline__ int crow(int r, int hi) { return (r & 3) + 8 * (r >> 2) + 4 * hi; }
__device__ __forceinline__ unsigned cvtpk(float lo, float hi) { unsigned r; asm volatile("v_cvt_pk_bf16_f32 %0, %1, %2" : "=v"(r) : "v"(lo), "v"(hi)); return r; }
template <bool FIRST> __device__ __forceinline__ void partialSM(f32x16& p0, f32x16& p1, float& mhat, f32x16& negm, float& alpha) {
    float pmax = p0[0];
#pragma unroll
    for (int r = 1; r < 16; ++r) pmax = fmaxf(pmax, p0[r]);
#pragma unroll
    for (int r = 0; r < 16; ++r) pmax = fmaxf(pmax, p1[r]);
    { auto rr = __builtin_amdgcn_permlane32_swap(__float_as_uint(pmax), __float_as_uint(pmax), false, false); pmax = fmaxf(__uint_as_float(rr[0]), __uint_as_float(rr[1])); }
    alpha = 1.f;
    if (FIRST || __builtin_expect(!__all(pmax <= THRL), 0)) {
        const float dl = FIRST ? pmax : fmaxf(pmax, 0.f); mhat += dl;
#pragma unroll
        for (int r = 0; r < 16; ++r) { p0[r] -= dl; p1[r] -= dl; }
#pragma unroll
        for (int r = 0; r < 16; ++r) negm[r] = -mhat;
        asm volatile("" : "+v"(negm));
        alpha = __builtin_amdgcn_exp2f(-dl);
    }
#pragma unroll
    for (int r = 0; r < 16; ++r) p0[r] = __builtin_amdgcn_exp2f(p0[r]);
}
__device__ __forceinline__ void finishSM(f32x16& p0, f32x16& p1, bf16x8& pa0, bf16x8& pa1, bf16x8& pa2, bf16x8& pa3) {
#pragma unroll
    for (int r = 0; r < 16; ++r) p1[r] = __builtin_amdgcn_exp2f(p1[r]);
#define PK4(P, BASE, OUT) do { unsigned a0 = cvtpk(P[BASE + 0], P[BASE + 1]), a1 = cvtpk(P[BASE + 2], P[BASE + 3]);   \
    unsigned b0 = cvtpk(P[BASE + 4], P[BASE + 5]), b1 = cvtpk(P[BASE + 6], P[BASE + 7]);                              \
    auto r0 = __builtin_amdgcn_permlane32_swap(a0, b0, false, false); auto r1 = __builtin_amdgcn_permlane32_swap(a1, b1, false, false); \
    u32x4 w = {r0[0], r1[0], r0[1], r1[1]}; OUT = __builtin_bit_cast(bf16x8, w); } while (0)
    PK4(p0, 0, pa0); PK4(p0, 8, pa1); PK4(p1, 0, pa2); PK4(p1, 8, pa3);
#undef PK4
}
__device__ __forceinline__ void qkt(f32x16& p0, f32x16& p1, const LAS unsigned char* Ks, const bf16x8* qr, const f32x16& negm, int r32, int hi) {
    const LAS unsigned char* kb = Ks + hi * 1024 + r32 * 16;
#pragma unroll
    for (int d0 = 0; d0 < DQK / 16; ++d0) {
        const bf16x8 b0 = *(const LAS bf16x8*)(kb + d0 * 2048);
        const bf16x8 b1 = *(const LAS bf16x8*)(kb + d0 * 2048 + 512);
        if (d0 == 0) { p0 = __builtin_amdgcn_mfma_f32_32x32x16_bf16(b0, qr[0], negm, 0, 0, 0); p1 = __builtin_amdgcn_mfma_f32_32x32x16_bf16(b1, qr[0], negm, 0, 0, 0); }
        else { p0 = __builtin_amdgcn_mfma_f32_32x32x16_bf16(b0, qr[d0], p0, 0, 0, 0); p1 = __builtin_amdgcn_mfma_f32_32x32x16_bf16(b1, qr[d0], p1, 0, 0, 0); } }
}
__device__ __forceinline__ int v_rd_base(int lane) { return ((lane & 3) << 3) | (((lane >> 2) & 3) << 6) | (((lane >> 4) & 1) << 5) | (((lane >> 5) & 1) << 8); }
__device__ __forceinline__ s16x4 vtr(const LAS unsigned char* p) { return __builtin_bit_cast(s16x4, __builtin_amdgcn_ds_read_tr16_b64_v4i16((LAS v4i16_t*)p)); }
__device__ __forceinline__ void pv(f32x16* o, f32x16& ol, const LAS unsigned char* vp, bf16x8 ones, bf16x8 pa0, bf16x8 pa1, bf16x8 pa2, bf16x8 pa3) {
#define PVS(ks, pa) do { _Pragma("unroll") for (int d0 = 0; d0 < 2; ++d0) { const s16x4 lo = vtr(vp + d0 * 512 + (ks) * 2048), hh = vtr(vp + d0 * 512 + (ks) * 2048 + 1024); \
        o[d0] = __builtin_amdgcn_mfma_f32_32x32x16_bf16(pa, ((bf16x8){lo[0], lo[1], lo[2], lo[3], hh[0], hh[1], hh[2], hh[3]}), o[d0], 0, 0, 0); } \
        ol = __builtin_amdgcn_mfma_f32_32x32x16_bf16(pa, ones, ol, 0, 0, 0); } while (0)
    PVS(0, pa0); PVS(1, pa1); PVS(2, pa2); PVS(3, pa3);
#undef PVS
}
__device__ __forceinline__ void attn_unit(const bf16_t* __restrict__ Q, const bf16_t* __restrict__ K, const bf16_t* __restrict__ V, bf16_t* __restrict__ MIX, float* __restrict__ ssq_a,
                                          int row0, int h, int s0, int seq, LAS unsigned char* lds) {
    int tid = threadIdx.x; asm volatile("" : "+v"(tid));
    const int wid = __builtin_amdgcn_readfirstlane(tid >> 6), lane = tid & 63, r32 = lane & 31, hi = lane >> 5;
    LAS unsigned char* V_lds = lds + OFF_V; LAS unsigned char* K_lds = lds + OFF_K;
    LAS float* al_l = (LAS float*)(lds + OFF_WS) + wid * 32;
    float mhat = 0.f; f32x16 o[2] = {}; f32x16 ol = {}; f32x16 negm = {}; bf16x8 qr[DQK / 16];
    const bf16x8 ones = {0x3F80, 0x3F80, 0x3F80, 0x3F80, 0x3F80, 0x3F80, 0x3F80, 0x3F80};
    const bf16_t* Qw = Q + (size_t)(row0 + wid * QBLK + r32) * 768 + h * DQK + hi * 8;
#pragma unroll
    for (int d0 = 0; d0 < DQK / 16; ++d0) qr[d0] = *(const bf16x8*)(Qw + d0 * 16);
    const bf16_t* ksrc0 = K + (size_t)(s0 + lane) * 768 + h * DQK + wid * 8;
    const bf16_t* ksrc1 = ksrc0 + 64;
    const int vkk = 8 * wid + ((lane & 31) >> 2), vk = (vkk & ~0xC) | ((vkk & 4) << 1) | ((vkk & 8) >> 1);
    const bf16_t* vsrc = V + (size_t)(s0 + vk) * 512 + h * DV + 32 * (lane >> 5) + 8 * (lane & 3);
    const bool k2 = wid < 4;
#define DMA(t, slot) do { const size_t kk0_ = (size_t)(t) * KVBLK; \
    __builtin_amdgcn_global_load_lds((const unsigned*)(ksrc0 + kk0_ * 768), (LAS unsigned*)(K_lds + (slot) * SHM_K + wid * 1024), 16, 0, 0); \
    __builtin_amdgcn_global_load_lds((const unsigned*)(vsrc + kk0_ * 512), (LAS unsigned*)(V_lds + (slot) * SHM_V + wid * 1024), 16, 0, 0); \
    if (k2) __builtin_amdgcn_global_load_lds((const unsigned*)(ksrc1 + kk0_ * 768), (LAS unsigned*)(K_lds + (slot) * SHM_K + (8 + wid) * 1024), 16, 0, 0); } while (0)
#define RESC(a) do { if (__any((a) < 1.f)) { if (hi == 0) al_l[r32] = (a); asm volatile("s_waitcnt lgkmcnt(0)" ::: "memory"); \
    _Pragma("unroll") for (int r = 0; r < 16; ++r) { const float f_ = al_l[crow(r, hi)]; o[0][r] *= f_; o[1][r] *= f_; ol[r] *= f_; } } } while (0)
    const LAS unsigned char* vp0 = V_lds + v_rd_base(lane);
    f32x16 pA0, pA1, pB0, pB1; float alA, alB; bf16x8 pa0, pa1, pa2, pa3; const int NT = seq / KVBLK;
    int sp = 0, sc = 0, sn = 1;
#define ROT() do { sp = sc; sc = sn; sn = (sn == NSLOT - 1) ? 0 : sn + 1; } while (0)
    DMA(0, 0); DMA(1, 1); __syncthreads();
    qkt(pA0, pA1, K_lds, qr, negm, r32, hi); partialSM<true>(pA0, pA1, mhat, negm, alA);
    ROT();
    for (int j = 1; j + 1 < NT; j += 2) {
        DMA(j + 1, sn);
        SBAR(); qkt(pB0, pB1, K_lds + sc * SHM_K, qr, negm, r32, hi);
        finishSM(pA0, pA1, pa0, pa1, pa2, pa3); SBAR();
        pv(o, ol, vp0 + sp * SHM_V, ones, pa0, pa1, pa2, pa3); partialSM<false>(pB0, pB1, mhat, negm, alB);
        RESC(alB); __syncthreads(); ROT();
        if (j + 2 < NT) DMA(j + 2, sn);
        SBAR(); qkt(pA0, pA1, K_lds + sc * SHM_K, qr, negm, r32, hi);
        finishSM(pB0, pB1, pa0, pa1, pa2, pa3); SBAR();
        pv(o, ol, vp0 + sp * SHM_V, ones, pa0, pa1, pa2, pa3); partialSM<false>(pA0, pA1, mhat, negm, alA);
        RESC(alA); __syncthreads(); ROT();
    }
    SBAR(); qkt(pB0, pB1, K_lds + sc * SHM_K, qr, negm, r32, hi);
    finishSM(pA0, pA1, pa0, pa1, pa2, pa3); SBAR();
    pv(o, ol, vp0 + sp * SHM_V, ones, pa0, pa1, pa2, pa3); partialSM<false>(pB0, pB1, mhat, negm, alB);
    RESC(alB);
    finishSM(pB0, pB1, pa0, pa1, pa2, pa3); SBAR();
    pv(o, ol, vp0 + sc * SHM_V, ones, pa0, pa1, pa2, pa3);
#undef ROT
    bf16_t* Ow = MIX + (size_t)(row0 + wid * QBLK) * 1024 + h * DV;
#pragma unroll
    for (int r = 0; r < 16; ++r) { const int orow = crow(r, hi); const float rl = __builtin_amdgcn_rcpf(ol[r]);
        const float a = o[0][r] * rl, b = o[1][r] * rl;
        Ow[(size_t)orow * 1024 + r32] = (bf16_t)f2bf(a); Ow[(size_t)orow * 1024 + 32 + r32] = (bf16_t)f2bf(b);
        float ss = a * a + b * b;
        ss += __shfl_xor(ss, 1); ss += __shfl_xor(ss, 2); ss += __shfl_xor(ss, 4); ss += __shfl_xor(ss, 8); ss += __shfl_xor(ss, 16);
        if (r32 == 0) atomicAdd(ssq_a + row0 + wid * QBLK + orow, ss); }
    __syncthreads();
#undef DMA
#undef RESC
}
__device__ __forceinline__ void attn_phase(const bf16_t* Q, const bf16_t* K, const bf16_t* V, bf16_t* MIX, float* ssq_a, int vcu, int G, LAS unsigned char* lds) {
    constexpr int NU = 512 + 1024;
    const int nmine = (G == 256) ? 6 : (NU - vcu + G - 1) / G;
#pragma unroll 1
    for (int i = 0; i < nmine; ++i) {
        int u;
        if (G == 256) { const int x = vcu >> 5, l = vcu & 31; u = (i < 2) ? x * 64 + l + 32 * i : 512 + (8 * x) * 16 + (i - 2) * 32 + l; }
        else u = vcu + i * G;
        int row0, h, s0, seq;
        if (u < 512) { row0 = M_PROMPT + (u & 63) * 256; h = u >> 6; s0 = M_PROMPT; seq = SEQ_S; }
        else { const int pu = u - 512, bh = pu >> 4, qb = pu & 15, b = bh >> 3; h = bh & 7; s0 = b * SEQ_P; row0 = s0 + qb * 256; seq = SEQ_P; }
        attn_unit(Q, K, V, MIX, ssq_a, row0, h, s0, seq, lds);
    }
}
#undef SBAR
}

__device__ __forceinline__ void ssm_scan1(const float* __restrict__ LST, bf16_t* __restrict__ UA, const float* __restrict__ AT, float* __restrict__ ESEG, int vb, int tid) {
    const int r = vb * (NWAVES * 64) + tid;
    if (r >= 12 * 4096) return;
    const int item = r >> 12, rem = r & 4095, dir = rem >> 11, g = (rem >> 6) & 31, n = rem & 63;
    const int c0 = item * 256;
    const float ar = AT[2 * ((dir * NG + g) * NS + n)], ai = AT[2 * ((dir * NG + g) * NS + n) + 1];
    const size_t off = (size_t)g * 256 + dir * 128 + n;
    const int step = dir == 0 ? 1 : -1; const int c = dir == 0 ? c0 : c0 + 255;
    float xr = 0.f, xi = 0.f;
    const float* lp = LST + (size_t)c * 8192 + off;
    bf16_t* up = UA + (size_t)c * 16384 + g * 512 + 256 + dir * 128 + n;
#pragma unroll 1
    for (int b = 0; b < 256; b += 64) {
        int st = step; asm volatile("" : "+v"(st));
        const long ls = (long)st * 8192, us = (long)st * 16384;
        float lr[64], li[64];
#pragma unroll
        for (int k = 0; k < 64; ++k) { lr[k] = lp[0]; li[k] = lp[64]; lp += ls; }
#pragma unroll
        for (int k = 0; k < 64; ++k) {
            up[0] = (bf16_t)f2bf(xr); up[64] = (bf16_t)f2bf(xi); up += us;
            const float tr = ar * xr - ai * xi + lr[k], ti = ar * xi + ai * xr + li[k]; xr = tr; xi = ti;
        }
    }
    if (item >= 8) { float* e = ESEG + ((size_t)(item - 8) * 4096 + rem) * 2; e[0] = xr; e[1] = xi; }
}
__device__ __forceinline__ void ssm_scan2(bf16_t* __restrict__ UA, const float* __restrict__ ESEG, const float* lam_re, const float* lam_im, const float* log_dt, int gtid, int nthr) {
    for (int i = gtid; i < 768 * 4096; i += nthr) {
        const int rem = i & 4095, cc = i >> 12, dir = rem >> 11, g = (rem >> 6) & 31, n = rem & 63;
        const int q = cc >> 8, j = cc & 255, k = dir == 0 ? q + 1 : q;
        const int pi = (dir * NG + g) * NS + n;
        const float lr = lam_re[pi], li = lam_im[pi], dt = expf(log_dt[dir * NG + g]);
        const cpx A = apow(lr, li, dt, (float)(CT * 256));
        cpx carry = {0.f, 0.f};
        if (dir == 0) { for (int kk = 0; kk < k; ++kk) { const float* e = ESEG + ((size_t)kk * 4096 + rem) * 2; const cpx t = cmul(A, carry); carry = {t.r + e[0], t.i + e[1]}; } }
        else { for (int kk = 3; kk > k; --kk) { const float* e = ESEG + ((size_t)kk * 4096 + rem) * 2; const cpx t = cmul(A, carry); carry = {t.r + e[0], t.i + e[1]}; } }
        const cpx f = cmul(apow(lr, li, dt, (float)(CT * (dir == 0 ? j : 255 - j))), carry);
        bf16_t* up = UA + (size_t)(2048 + k * 256 + j) * 16384 + g * 512 + 256 + dir * 128 + n;
        up[0] = (bf16_t)f2bf(bf2f(up[0]) + f.r); up[64] = (bf16_t)f2bf(bf2f(up[64]) + f.i);
    }
}

#define XB_TMO      128
#define XB_XCNT(j)  (256  + 64 * (j))
#define XB_XSUB(j)  (1280 + 64 * (j))
#define XB_XGEN(j)  (2304 + 64 * (j))
#define XB_TOP      3328
#define XB_TOPGEN   3392
#define XCD_BAR_WORDS 3456
#define XB_SPIN_CAP (1u << 22)
__device__ __forceinline__ unsigned xb_ld(unsigned* p)              { return __hip_atomic_load(p, __ATOMIC_RELAXED, __HIP_MEMORY_SCOPE_AGENT); }
__device__ __forceinline__ unsigned xb_add(unsigned* p, unsigned v) { return __hip_atomic_fetch_add(p, v, __ATOMIC_RELAXED, __HIP_MEMORY_SCOPE_AGENT); }
__device__ __forceinline__ unsigned xb_xcc_id() { return (unsigned)__builtin_amdgcn_s_getreg((3 << 11) | 20) & 0xFu; }
#define XB_SPIN(cond, bar) do { unsigned _sp = 0; while (cond) { __builtin_amdgcn_s_sleep(1); \
    if ((++_sp & 255u) == 0u) { if (xb_ld(&(bar)[XB_TMO])) break; if (_sp > XB_SPIN_CAP) { atomicAdd(&(bar)[XB_TMO], 1u); break; } } } } while (0)
struct XcdBarrier { unsigned* bar; unsigned x; volatile LAS unsigned* st; };
__device__ __forceinline__ XcdBarrier xcd_barrier_post(unsigned* bar, volatile LAS unsigned* st) {
    XcdBarrier b; b.bar = bar; b.x = xb_xcc_id(); b.st = st;
    if (threadIdx.x == 0) (void)xb_add(&bar[XB_XCNT(b.x)], 1u);
    return b;
}
__device__ __forceinline__ void xcd_barrier_complete(unsigned* bar, unsigned x, unsigned& nloc, unsigned& nx) {
    const unsigned G = gridDim.x * gridDim.y * gridDim.z;
    unsigned sum, cnt, mine, sp = 0u;
    for (;;) {
        sum = 0u; cnt = 0u; mine = 0u;
#pragma unroll
        for (unsigned j = 0; j < 16; ++j) { const unsigned c = xb_ld(&bar[XB_XCNT(j)]); sum += c; cnt += (c > 0u) ? 1u : 0u; mine = (j == x) ? c : mine; }
        if (sum == G) break;
        __builtin_amdgcn_s_sleep(1);
        if ((++sp & 255u) == 0u) { if (xb_ld(&bar[XB_TMO])) break; if (sp > XB_SPIN_CAP) { atomicAdd(&bar[XB_TMO], 1u); break; } }
    }
    nloc = mine > 0u ? mine : 1u; nx = cnt > 0u ? cnt : 1u;
}
__device__ __forceinline__ void xcd_barrier(const XcdBarrier& b) {
    asm volatile("s_waitcnt vmcnt(0)" ::: "memory");
    __syncthreads();
    if (threadIdx.x == 0) {
        unsigned* bar = b.bar;
        __builtin_amdgcn_s_waitcnt(0);
        unsigned nloc = b.st[0], nx = b.st[1];
        if (nloc == 0u) { xcd_barrier_complete(bar, b.x, nloc, nx); b.st[0] = nloc; b.st[1] = nx; }
        const unsigned old = xb_add(&bar[XB_XSUB(b.x)], 1u);
        const unsigned gen = old / nloc;
        if (old + 1u == (gen + 1u) * nloc) {
            __builtin_amdgcn_fence(__ATOMIC_RELEASE, "agent");
            asm volatile("s_waitcnt vmcnt(0)" ::: "memory");
            const unsigned og = xb_add(&bar[XB_TOP], 1u);
            const unsigned tg = og / nx;
            if (og + 1u == (tg + 1u) * nx) xb_add(&bar[XB_TOPGEN], 1u);
            else XB_SPIN(xb_ld(&bar[XB_TOPGEN]) == tg, bar);
            __builtin_amdgcn_fence(__ATOMIC_ACQUIRE, "agent");
            xb_add(&bar[XB_XGEN(b.x)], 1u);
            asm volatile("s_waitcnt vmcnt(0)" ::: "memory");
        } else {
            XB_SPIN(xb_ld(&bar[XB_XGEN(b.x)]) == gen, bar);
            __builtin_amdgcn_fence(__ATOMIC_ACQUIRE, "agent");
            asm volatile("s_waitcnt vmcnt(0)" ::: "memory");
        }
    }
    __syncthreads();
}

constexpr int LDS_BYTES = 147456, MISC_OFF = 131072 + 320;
constexpr int N_PHASES = 15;
constexpr int PROBE_ABL = 0;
constexpr unsigned PROBE_MASK = 0u;
constexpr int CW_BAR = 4096;
__global__ void __launch_bounds__(NWAVES * 64, 2) mega(Params p) {
    extern __shared__ __attribute__((aligned(16))) unsigned char lds_raw[];
    LAS unsigned char* lds = (LAS unsigned char*)lds_raw;
    const int G = gridDim.x, bx = blockIdx.x, tid = threadIdx.x;
    const int vcu = (G % 8 == 0) ? (bx % 8) * (G / 8) + bx / 8 : bx;
    unsigned char* ws = p.ws;
    volatile LAS unsigned* MISC = (volatile LAS unsigned*)(lds + MISC_OFF);
    for (int u = tid; u < (LDS_BYTES - 131072) / 4; u += NWAVES * 64) ((LAS unsigned*)(lds + 131072))[u] = 0u;
    __syncthreads();
    const int lo = p.ph_lo, hi = p.ph_hi;
    XcdBarrier bar; bar.bar = (unsigned*)(ws + WS_CTL) + CW_BAR; bar.x = 0; bar.st = nullptr;
    if (hi - lo > 1) bar = xcd_barrier_post((unsigned*)(ws + WS_CTL) + CW_BAR, MISC + 8);
#ifndef PH_MASK
#define PH_MASK 0xFFFFu
#endif
#define IN(k) (((PH_MASK >> (k)) & 1u) && lo <= (k) && (k) < hi)
#define SEAM(k) do { if (IN(k) && IN((k) + 1)) xcd_barrier(bar); } while (0)
    float* stat = (float*)(ws + WS_STAT);
    const float* cosT = (const float*)(ws + WS_ROPE); const float* sinT = cosT + SEQ_S * 16;
    bf16_t* PROJ = (bf16_t*)(ws + WS_PROJ); bf16_t* GB = (bf16_t*)(ws + WS_PROJ); bf16_t* UA = (bf16_t*)(ws + WS_UA); bf16_t* X1B = (bf16_t*)(ws + WS_UA);
    bf16_t* XB = (bf16_t*)(ws + WS_XB); float* LST = (float*)(ws + WS_XB); bf16_t* HB = (bf16_t*)(ws + WS_XB); bf16_t* MIX = (bf16_t*)(ws + WS_MIX);
    bf16_t* Qb = (bf16_t*)p.out; bf16_t* Kb = Qb + (size_t)M_TOK * 768; bf16_t* Vb = Kb + (size_t)M_TOK * 768;

#define REPS(k) for (int rep = ((PROBE_MASK >> (k)) & 1u) ? 0 : 1; rep < 2; ++rep)
#define DRYBAR() do { if (rep == 0) xcd_barrier(bar); } while (0)
#define SQ(st_) (rep == 0 ? stat + 7 * M_TOK : stat + (st_) * M_TOK)
    if (IN(0)) REPS(0) { prologue(p, lds, vcu, G); DRYBAR(); } SEAM(0);
    if (IN(1)) REPS(1) { EpiProj e{stat + ST_RSTD1 * M_TOK, PROJ, UA, cosT, sinT, SQ(ST_SSQ), SQ(ST_SSKV)};
        pg8::run_gemm(lds, XB, 1024, 0, (const bf16_t*)(ws + WS_WIN), 1024, M_TOK, 1024, 1024, e, G, bx); DRYBAR(); } SEAM(1);
    if (IN(2)) REPS(2) {
        { EpiQ e{stat + ST_SSQ * M_TOK, Qb, cosT, sinT}; pg8::run_gemm(lds, PROJ, 512, 0, (const bf16_t*)(ws + WS_WUQ), 256, M_TOK, 768, 256, e, G, bx); }
        { EpiKV e{stat + ST_SSKV * M_TOK, PROJ, Kb, Vb}; pg8::run_gemm(lds, PROJ + 256, 512, 0, (const bf16_t*)(ws + WS_WUKV), 128, M_TOK, 1024, 128, e, G, bx); }
        { EpiLst e{LST}; pg8::run_gemm(lds, UA, 16384, 512, (const bf16_t*)(ws + WS_SP), 256, NCHUNK, 8192, 256, e, G, bx); }
        DRYBAR(); } SEAM(2);
    if (IN(3)) REPS(3) { ssm_scan1(LST, UA, (const float*)(ws + WS_AT), (float*)(ws + WS_ESEG), vcu, tid); DRYBAR(); } SEAM(3);
    if (IN(4)) REPS(4) { if (rep == 1) ssm_scan2(UA, (const float*)(ws + WS_ESEG), p.in[8], p.in[9], p.in[10], vcu * (NWAVES * 64) + tid, G * NWAVES * 64);
        att::attn_phase(Qb, Kb, Vb, MIX, SQ(ST_SSA), vcu, G, lds);
        DRYBAR(); } SEAM(4);
    if (IN(5)) REPS(5) { EpiSsmOut e{GB}; pg8::run_gemm(lds, UA, 16384, 512, (const bf16_t*)(ws + WS_MQ), 512, NCHUNK, 8192, 512, e, G, bx); DRYBAR(); } SEAM(5);
    if (IN(6)) REPS(6) { EpiGlu e{GB, p.in[17], MIX, SQ(ST_SSS)}; pg8::run_gemm(lds, GB, 512, 0, (const bf16_t*)(ws + WS_WGLU), 512, M_TOK, 512, 512, e, G, bx); DRYBAR(); } SEAM(6);
    if (IN(7)) REPS(7) { EpiOut e{p.in[0], p.in[1], stat + ST_SSS * M_TOK, p.out, X1B, SQ(ST_SSX1)};
        pg8::run_gemm(lds, MIX, 1024, 0, (const bf16_t*)(ws + WS_WOUT), 1024, M_TOK, 1024, 1024, e, G, bx, 8, stat + ST_SSA * M_TOK, stat + ST_SSS * M_TOK); DRYBAR(); } SEAM(7);
#pragma unroll 1
    for (int th = 0; th < 3; ++th) {
        const int r0 = th * 16384;
        if (IN(8 + 2 * th)) REPS(8) { EpiMlp1 e{stat + ST_SSX1 * M_TOK, HB, r0, 0};
            pg8::run_gemm(lds, X1B + (size_t)r0 * DM, 1024, 0, (const bf16_t*)(ws + WS_W1), 1024, 16384, 4096, 1024, e, G, bx); DRYBAR(); } SEAM(8 + 2 * th);
        if (IN(9 + 2 * th)) REPS(9) { EpiMlp2 e{p.out + (size_t)r0 * DM, rep == 0 ? (float*)(ws + WS_END) : p.out + (size_t)r0 * DM, (rep == 0 ? stat + 7 * M_TOK : stat + ST_SSX2 * M_TOK) + r0, r0, 0};
            pg8::run_gemm(lds, HB, 4096, 0, (const bf16_t*)(ws + WS_W2), 4096, 16384, 1024, 4096, e, G, bx); DRYBAR(); } SEAM(9 + 2 * th);
    }
    if (IN(14)) final_norm_rows(p.out, stat + ST_SSX2 * M_TOK, p.in[24], vcu * NWAVES + (tid >> 6), G * NWAVES, tid & 63);
#undef REPS
#undef DRYBAR
#undef SQ
#undef IN
#undef SEAM
}

extern "C" void kernel_launch(void* const* d_in, const int* in_sizes, int n_in, void* d_out, int out_size, void* d_ws, size_t ws_size, hipStream_t stream) {
    static int ok = 0;
    if (ok == 0) {
        if (n_in != 25 || out_size != M_TOK * DM || ws_size < WS_END + 64 * MiB) { fprintf(stderr, "kernel_launch: unexpected shapes n_in %d out %d ws %zu\n", n_in, out_size, ws_size); ok = -1; return; }
        if (hipFuncSetAttribute((const void*)mega, hipFuncAttributeMaxDynamicSharedMemorySize, LDS_BYTES) != hipSuccess) { fprintf(stderr, "kernel_launch: LDS attribute failed\n"); ok = -1; return; }
        ok = 1;
    }
    if (ok < 0) return;
    Params p{};
    for (int i = 0; i < 25; ++i) p.in[i] = (const float*)d_in[i];
    p.out = (float*)d_out; p.ws = (unsigned char*)d_ws;
    unsigned char* ws = (unsigned char*)d_ws;
    float* stat = (float*)(ws + WS_STAT);
    const float* cosT = (const float*)(ws + WS_ROPE); const float* sinT = cosT + SEQ_S * 16;
    bf16_t* PROJ = (bf16_t*)(ws + WS_PROJ); bf16_t* GB = (bf16_t*)(ws + WS_PROJ); bf16_t* UA = (bf16_t*)(ws + WS_UA); bf16_t* X1B = (bf16_t*)(ws + WS_UA);
    bf16_t* XB = (bf16_t*)(ws + WS_XB); float* YB = (float*)(ws + WS_XB); bf16_t* HB = (bf16_t*)(ws + WS_XB); bf16_t* MIX = (bf16_t*)(ws + WS_MIX);
    bf16_t* Qb = (bf16_t*)d_out; bf16_t* Kb = Qb + (size_t)M_TOK * 768; bf16_t* Vb = Kb + (size_t)M_TOK * 768;
    (void)hipMemsetAsync(ws + WS_CTL, 0, 1 * MiB, stream);
#define MEGA(a, b) do { p.ph_lo = (a); p.ph_hi = (b); hipLaunchKernelGGL(mega, dim3(256), dim3(512), LDS_BYTES, stream, p); } while (0)
    MEGA(0, N_PHASES);
#undef MEGA
}
```
